# Optimizing an MI355X kernel written in HIP

```python
import math
import jax, jax.numpy as jnp
from jax import lax
import numpy as np


D_MODEL = 1024
BATCH = 8
SEQ = 4096
DEPTH = 2

MEM_LEN = 256
DA_HEADS = 4
DA_QK_DIM = 64
DA_V_DIM = 2 * DA_QK_DIM
DA_QK_WIDTH = DA_HEADS * 2 * DA_QK_DIM
DA_WIDTH = DA_HEADS * DA_V_DIM
Q_BLOCK = 128
HG_HEADS = 4
HG_K = 128
HG_V = 128
HG_WIDTH = HG_HEADS * HG_K
HG_CHUNK = 64
CA_HEADS = 4
CA_DIM = 128
CA_WIDTH = CA_HEADS * CA_DIM
N_BRANCH = 3
IN_WIDTHS = (DA_QK_WIDTH, DA_QK_WIDTH, DA_WIDTH,
             HG_WIDTH, HG_WIDTH, HG_HEADS * HG_V, HG_HEADS * HG_V,
             CA_WIDTH, N_BRANCH * D_MODEL)
IN_TOTAL = sum(IN_WIDTHS)
N_EXPERTS = 16
N_GROUPS = 4
EXPERTS_PER_GROUP = N_EXPERTS // N_GROUPS
TOP_K = 2
D_EXPERT = 512
EPS = 1e-6

kernel_name = "hybrid_diffattn_hgrn2_memxattn_groupmoe"


def rmsnorm(x, g):
    xf = x.astype(jnp.float32)
    y = xf * lax.rsqrt(jnp.mean(xf * xf, axis=-1, keepdims=True) + EPS)
    return (y * g.astype(jnp.float32)).astype(x.dtype)


def alibi_slopes(n):
    return jnp.asarray([2.0 ** (-8.0 * (i + 1) / n) for i in range(n)], dtype=jnp.float32)


def diff_attention(q, k, v, lam, lam_init, sub_g):
    B, S = q.shape[0], q.shape[1]
    nb = S // Q_BLOCK
    slopes = alibi_slopes(DA_HEADS)
    scale = DA_QK_DIM ** -0.5
    kpos = jnp.arange(S)
    qb = q.reshape(B, nb, Q_BLOCK, DA_HEADS, 2, DA_QK_DIM).transpose(1, 0, 2, 3, 4, 5)

    def block(args):
        qi, bi = args
        qpos = bi * Q_BLOCK + jnp.arange(Q_BLOCK)
        s = jnp.einsum('bqhmd,bkhmd->bhmqk', qi, k,
                       preferred_element_type=jnp.float32) * scale
        dist = (qpos[:, None] - kpos[None, :]).astype(jnp.float32)
        bias = -slopes[:, None, None, None] * dist[None, None]
        s = jnp.where(qpos[:, None] >= kpos[None, :], s + bias, -jnp.inf)
        p = jax.nn.softmax(s, axis=-1)
        a = p[:, :, 0] - lam * p[:, :, 1]
        return jnp.einsum('bhqk,bkhd->bqhd', a.astype(v.dtype), v)

    o = lax.map(block, (qb, jnp.arange(nb)))
    o = o.transpose(1, 0, 2, 3, 4).reshape(B, S, DA_HEADS, DA_V_DIM)
    o = rmsnorm(o, sub_g) * (1.0 - lam_init)
    return o.reshape(B, S, DA_WIDTH)


def hgrn2(q, f_logit, i, g, lb, out_g):
    B, S = q.shape[0], q.shape[1]
    dt = i.dtype
    f = lb + (1.0 - lb) * jax.nn.sigmoid(f_logit.astype(jnp.float32))
    log_f = jnp.log(f)
    kk = 1.0 - f
    qq = jax.nn.silu(q.astype(jnp.float32))
    vv = i.astype(jnp.float32)
    C = HG_CHUNK
    nc = S // C

    def to_chunks(t):
        return t.reshape(B, nc, C, HG_HEADS, t.shape[-1]).transpose(1, 0, 3, 2, 4)

    qc, kc, vc, lfc = to_chunks(qq), to_chunks(kk), to_chunks(vv), to_chunks(log_f)
    causal = jnp.tril(jnp.ones((C, C), dtype=bool))

    def step(state, xs):
        qt, kt, vt, lft = xs
        bcum = jnp.cumsum(lft, axis=2)
        diff = bcum[:, :, :, None, :] - bcum[:, :, None, :, :]
        decay = jnp.exp(jnp.where(causal[:, :, None], diff, -jnp.inf))
        attn = jnp.einsum('bhtk,bhsk,bhtsk->bhts', qt, kt, decay)
        o = jnp.einsum('bhts,bhsv->bhtv', attn, vt)
        o = o + jnp.einsum('bhtk,bhkv->bhtv', qt * jnp.exp(bcum), state)
        btot = bcum[:, :, -1:, :]
        new_state = (jnp.exp(btot)[:, :, 0, :, None] * state
                     + jnp.einsum('bhsk,bhsv->bhkv', kt * jnp.exp(btot - bcum), vt))
        return new_state, o

    state0 = jnp.zeros((B, HG_HEADS, HG_K, HG_V), jnp.float32)
    _, o = lax.scan(step, state0, (qc, kc, vc, lfc))
    o = o.transpose(1, 0, 3, 2, 4).reshape(B, S, HG_HEADS, HG_V).astype(dt)
    o = rmsnorm(o, out_g) * jax.nn.silu(g)
    return o.reshape(B, S, HG_HEADS * HG_V)


def cross_attention(q, mk, mv):
    B, S = q.shape[0], q.shape[1]
    s = jnp.einsum('bshd,bmhd->bhsm', q, mk,
                   preferred_element_type=jnp.float32) * CA_DIM ** -0.5
    p = jax.nn.softmax(s, axis=-1)
    o = jnp.einsum('bhsm,bmhd->bshd', p.astype(mv.dtype), mv)
    return o.reshape(B, S, CA_WIDTH)


def grouped_moe(h, w_router, router_bias, w_gate, w_up, w_down):
    B, S, D = h.shape
    t = h.reshape(B * S, D)
    scores = jax.nn.sigmoid(jnp.dot(t, w_router, preferred_element_type=jnp.float32))
    sel = scores + router_bias.astype(jnp.float32)
    grp = sel.reshape(-1, N_GROUPS, EXPERTS_PER_GROUP)
    grp_score = jnp.sum(lax.top_k(grp, TOP_K)[0], axis=-1)
    best = jnp.argmax(grp_score, axis=-1)
    in_group = jnp.repeat(jax.nn.one_hot(best, N_GROUPS, dtype=jnp.bool_), EXPERTS_PER_GROUP, axis=-1)
    _, idx = lax.top_k(jnp.where(in_group, sel, -jnp.inf), TOP_K)
    wts = jnp.take_along_axis(scores, idx, axis=-1)
    wts = wts / jnp.sum(wts, axis=-1, keepdims=True)
    combine = jnp.sum(jax.nn.one_hot(idx, N_EXPERTS, dtype=jnp.float32) * wts[..., None], axis=1)
    combine = combine.astype(t.dtype)
    y = jnp.zeros_like(t)
    for e in range(N_EXPERTS):
        a = jax.nn.silu(t @ w_gate[e]) * (t @ w_up[e])
        y = y + (a * combine[:, e:e + 1]) @ w_down[e]
    return y.reshape(B, S, D)


def setup_inputs(seed: int = 0) -> dict:
    key = jax.random.key(seed)
    ks = jax.random.split(key, 20)
    f32 = jnp.float32
    D = D_MODEL
    n = lambda k, shape, s: jax.random.normal(k, shape, f32) * s
    return {
        "x": n(ks[0], (BATCH, SEQ, D), 1.0),
        "mem": n(ks[1], (BATCH, MEM_LEN, D), 1.0),
        "g_mix": 1.0 + n(ks[2], (DEPTH, D), 0.02),
        "w_in": n(ks[3], (DEPTH, D, IN_TOTAL), D ** -0.5),
        "da_lambda": n(ks[4], (DEPTH, 4, DA_QK_DIM), 0.1),
        "da_sub_g": 1.0 + n(ks[5], (DEPTH, DA_V_DIM), 0.02),
        "hg_lower_bounds": n(ks[6], (DEPTH, HG_WIDTH), 0.1),
        "hg_out_g": 1.0 + n(ks[7], (DEPTH, HG_V), 0.02),
        "g_mem": 1.0 + n(ks[8], (DEPTH, D), 0.02),
        "w_mem_kv": n(ks[9], (DEPTH, D, 2 * CA_WIDTH), D ** -0.5),
        "w_branch": n(ks[10], (DEPTH, N_BRANCH, DA_WIDTH, D), DA_WIDTH ** -0.5),
        "w_out": n(ks[11], (DEPTH, D, D), 0.5 * D ** -0.5),
        "g_ffn": 1.0 + n(ks[12], (DEPTH, D), 0.02),
        "w_router": n(ks[13], (D, N_EXPERTS), D ** -0.5),
        "router_bias": n(ks[14], (N_EXPERTS,), 0.01),
        "w_exp_gate": n(ks[15], (DEPTH, N_EXPERTS, D, D_EXPERT), D ** -0.5),
        "w_exp_up": n(ks[16], (DEPTH, N_EXPERTS, D, D_EXPERT), D ** -0.5),
        "w_exp_down": n(ks[17], (DEPTH, N_EXPERTS, D_EXPERT, D), 0.5 * D_EXPERT ** -0.5),
        "g_final": 1.0 + n(ks[18], (D,), 0.02),
    }


def reference(x, mem, g_mix, w_in, da_lambda, da_sub_g, hg_lower_bounds, hg_out_g,
              g_mem, w_mem_kv, w_branch, w_out, g_ffn, w_router, router_bias,
              w_exp_gate, w_exp_up, w_exp_down, g_final):
    B, S, D = x.shape
    points = []
    acc = 0
    for w in IN_WIDTHS[:-1]:
        acc += w
        points.append(acc)
    lbs = jnp.cumsum(jax.nn.softmax(hg_lower_bounds.astype(jnp.float32), axis=0), axis=0)
    lbs = lbs - lbs[0]
    for l in range(DEPTH):
        h = rmsnorm(x, g_mix[l])
        proj = h @ w_in[l]
        da_q, da_k, da_v, hg_q, hg_f, hg_i, hg_g, ca_q, gates = jnp.split(proj, points, axis=-1)
        lam_init = 0.8 - 0.6 * math.exp(-0.3 * l)
        lp = da_lambda[l].astype(jnp.float32)
        lam = jnp.exp(jnp.sum(lp[0] * lp[1])) - jnp.exp(jnp.sum(lp[2] * lp[3])) + lam_init
        y_a = diff_attention(da_q.reshape(B, S, DA_HEADS, 2, DA_QK_DIM),
                             da_k.reshape(B, S, DA_HEADS, 2, DA_QK_DIM),
                             da_v.reshape(B, S, DA_HEADS, DA_V_DIM),
                             lam, lam_init, da_sub_g[l])
        y_b = hgrn2(hg_q.reshape(B, S, HG_HEADS, HG_K),
                    hg_f.reshape(B, S, HG_HEADS, HG_K),
                    hg_i.reshape(B, S, HG_HEADS, HG_V),
                    hg_g.reshape(B, S, HG_HEADS, HG_V),
                    lbs[l].reshape(HG_HEADS, HG_K), hg_out_g[l])
        mkv = rmsnorm(mem, g_mem[l]) @ w_mem_kv[l]
        mk, mv = jnp.split(mkv, 2, axis=-1)
        y_c = cross_attention(ca_q.reshape(B, S, CA_HEADS, CA_DIM),
                              mk.reshape(B, -1, CA_HEADS, CA_DIM),
                              mv.reshape(B, -1, CA_HEADS, CA_DIM))
        gt = jax.nn.sigmoid(gates.reshape(B, S, N_BRANCH, D))
        merged = (gt[:, :, 0] * (y_a @ w_branch[l, 0])
                  + gt[:, :, 1] * (y_b @ w_branch[l, 1])
                  + gt[:, :, 2] * (y_c @ w_branch[l, 2]))
        x = x + merged @ w_out[l]
        x = x + grouped_moe(rmsnorm(x, g_ffn[l]), w_router, router_bias,
                            w_exp_gate[l], w_exp_up[l], w_exp_down[l])
    return rmsnorm(x, g_final)
```

```cpp
#include <hip/hip_runtime.h>
#include <cstdio>
#include <cstdint>

#define LAS __attribute__((address_space(3)))
typedef unsigned short bf16_t;
typedef short bf16x8 __attribute__((ext_vector_type(8)));
typedef float f32x4 __attribute__((ext_vector_type(4)));
typedef float f32x2 __attribute__((ext_vector_type(2)));
typedef unsigned u32x4 __attribute__((ext_vector_type(4)));
typedef unsigned u32x2 __attribute__((ext_vector_type(2)));

constexpr int D = 1024, NBATCH = 8, SEQ = 4096, NTOK = NBATCH * SEQ, DEPTH = 2, MEMLEN = 256, NMEM = NBATCH * MEMLEN;
constexpr int HT = NTOK / 2;
constexpr int HB = NBATCH / 2;
constexpr int NE = 16, DE = 512;
constexpr int IN_TOTAL = 7168, MIXW = 4096, GATEW = 3072;
constexpr float EPS = 1e-6f;
constexpr float LOG2E = 1.4426950408889634f;
constexpr int MAXROWS = 65536 + NE * 256;

constexpr size_t MiB = 1u << 20;
constexpr size_t WS_CTL = 0;
constexpr size_t WS_LAM = 1 * MiB;
constexpr size_t WS_LBS = 1 * MiB + 4096;
constexpr size_t WS_WRT = 1 * MiB + 65536;
constexpr size_t WS_RS = 1 * MiB + 262144;
constexpr size_t WS_RSMEM = 1 * MiB + 393216;
constexpr size_t WS_TOKINFO = 1 * MiB + 524288;
constexpr size_t WS_CHUNKCNT = 2 * MiB;
constexpr size_t WS_TILEEXP = 2 * MiB + 16384;
constexpr size_t WS_NTILES = 2 * MiB + 20480;
constexpr size_t WS_ROWTOK = 2 * MiB + 65536;
constexpr size_t WS_ROWWT = 2 * MiB + 65536 + 327680;
constexpr size_t WS_ROWRS = 2 * MiB + 65536 + 2 * 327680;
constexpr size_t WS_POS = 3 * MiB + 524288;
constexpr size_t WS_MEMB = 4 * MiB;
constexpr size_t WS_XB = 8 * MiB;
constexpr size_t WS_BIG = 72 * MiB;
constexpr size_t WS_ST = 328 * MiB;
constexpr size_t WS_MKV = 344 * MiB;
constexpr size_t WS_WMIX = 352 * MiB;
constexpr size_t WMIX_LAYER = 21 * MiB, WMIX_BR = 14 * MiB, WMIX_OUT = 17 * MiB, WMIX_MEM = 19 * MiB;
constexpr size_t WS_WMOE = 394 * MiB;
constexpr size_t WMOE_LAYER = 24 * MiB, WMOE_D = 16 * MiB;
constexpr size_t WS_XB8 = 442 * MiB;
constexpr float YS8_SCALE = 16.f;
constexpr float W8_SCALE = 64.f, ACT8_SCALE = 8.f;
constexpr size_t WS_END = 490 * MiB;
constexpr size_t WS_KM2 = 262144;
constexpr size_t WS_WMAX = 393216;
constexpr size_t WS_WSC = 1 * MiB + 409600;
constexpr size_t WS_MOECNT = 32768, WS_MOETMO = 10496;
constexpr size_t WS_HGCNT = 196608, WS_SPINTMO = 10240;
constexpr size_t BG_PB = 0;
constexpr size_t PB_STRIDE = (size_t)HT * 512 * 2;
constexpr size_t BG_LOGF = 112 * MiB;
constexpr size_t BG_YCAT = 144 * MiB;
constexpr size_t BG_GATES = 0;
constexpr size_t BG_MERGED = 192 * MiB;
constexpr size_t BG_ACT = 0;
constexpr size_t BG_YSLOT = 68 * MiB;
enum { SL_QA = 0, SL_KA = 1, SL_VA = 2, SL_HQ = 3, SL_HV = 4, SL_HG = 5, SL_CQ = 6 };

struct Params {
    const float* in[19];
    float* out;
    unsigned char* ws;
    int l, half;
};

__device__ __forceinline__ float bf2f(bf16_t b) { return __uint_as_float(((unsigned)b) << 16); }
__device__ __forceinline__ unsigned f2bf(float f) { unsigned u = __float_as_uint(f); return (u + 0x7fffu + ((u >> 16) & 1u)) >> 16; }
typedef __bf16 bf16x2_t __attribute__((ext_vector_type(2)));
__device__ __forceinline__ unsigned cvt_pk_bf16(float lo, float hi) { const f32x2 v = {lo, hi}; return __builtin_bit_cast(unsigned, __builtin_convertvector(v, bf16x2_t)); }
__device__ __forceinline__ unsigned pk2(float lo, float hi) { return cvt_pk_bf16(lo, hi); }
__device__ __forceinline__ unsigned pk4_fp8(float a, float b, float c, float d) { int w = 0; w = __builtin_amdgcn_cvt_pk_fp8_f32(a, b, w, false); w = __builtin_amdgcn_cvt_pk_fp8_f32(c, d, w, true); return (unsigned)w; }
__device__ __forceinline__ unsigned pk4_i8(float a, float b, float c, float d) {
    const int ia = __float2int_rn(fminf(fmaxf(a, -127.f), 127.f)), ib = __float2int_rn(fminf(fmaxf(b, -127.f), 127.f)), ic = __float2int_rn(fminf(fmaxf(c, -127.f), 127.f)), id = __float2int_rn(fminf(fmaxf(d, -127.f), 127.f));
    return (unsigned)(ia & 255) | ((unsigned)(ib & 255) << 8) | ((unsigned)(ic & 255) << 16) | ((unsigned)id << 24); }
__device__ __forceinline__ float fsigmoid(float z) { return __builtin_amdgcn_rcpf(1.f + __expf(-z)); }
__device__ __forceinline__ float fsilu(float z) { return z * fsigmoid(z); }
__device__ __forceinline__ void lds_barrier() { asm volatile("s_waitcnt lgkmcnt(0)" ::: "memory"); __builtin_amdgcn_s_barrier(); asm volatile("" ::: "memory"); }
__device__ __forceinline__ float wave_sum(float v) {
#pragma unroll
    for (int o = 1; o < 64; o <<= 1) v += __shfl_xor(v, o);
    return v;
}
__device__ __forceinline__ float wave_max(float v) {
#pragma unroll
    for (int o = 1; o < 64; o <<= 1) v = fmaxf(v, __shfl_xor(v, o));
    return v;
}

namespace pg8 {
constexpr int BM = 256, BK = 64, HALF = 128, HTB = HALF * BK * 2, STAGE_BYTES = 8 * HTB, NXCD = 8, WGM = 8;
__host__ __device__ __forceinline__ int lds_byte(int r, int c) { const int st = (r >> 4) * 2 + (c >> 5), rr = r & 15, cc = c & 31, ob = rr * 64 + cc * 2; return st * 1024 + (ob ^ (((ob >> 9) & 1) << 5)); }
__host__ __device__ __forceinline__ void stage_rc(int b, int& R, int& C) { const int st = b / 1024, sb = b % 1024, swz = sb ^ (((sb >> 9) & 1) << 5); R = (st >> 1) * 16 + swz / 64; C = (st & 1) * 32 + (swz % 64) / 2; }
__host__ __device__ __forceinline__ int perm32(int rho) { const int n = rho >> 4, i = rho & 15; return 8 * (i >> 2) + 4 * n + (i & 3); }

struct Unit { int pm, pn; };
struct Gemm { const bf16_t* A; const bf16_t* Bt; int K; const float* cs; };

struct StaticOrder {
    static constexpr bool GATHER = false;
    int nM, nN, nwg, G, c;
    __device__ void init(int M, int N, int G_, int c_) { nM = M / BM; nN = N / BM; nwg = nM * nN; G = G_; c = c_; }
    __device__ void unit_of(long L, Unit& u) const {
        int wgid = (int)L; { const int q = nwg / NXCD, r = nwg % NXCD, xcd = wgid % NXCD, off = wgid / NXCD; wgid = (xcd < r ? xcd * (q + 1) : r * (q + 1) + (xcd - r) * q) + off; }
        const int nig = WGM * nN, gid = wgid / nig, fm = gid * WGM, gsz = (nM - fm) < WGM ? (nM - fm) : WGM;
        u.pm = fm + ((wgid % nig) % gsz); u.pn = (wgid % nig) / gsz;
    }
    __device__ bool next(int i, Unit& u) const {
        const long L = (long)i * G + c; if (L >= nwg) return false;
        unit_of(L, u); return true;
    }
    __device__ __forceinline__ void a_ready(const Unit&) const {}
    __device__ __forceinline__ void done(const Unit&) const {}
    __device__ __forceinline__ size_t b_off(const Unit& u, size_t tstep) const { return (size_t)u.pn * tstep; }
    __device__ __forceinline__ int b_key(const Unit&) const { return 0; }
    __device__ __forceinline__ size_t b_off_k(int, const Unit& u, size_t tstep) const { return (size_t)u.pn * tstep; }
    __device__ __forceinline__ int row(const Unit&, int) const { return 0; }
};
struct GatesOfMerge : StaticOrder {
    __device__ bool next(int i, Unit& u) const { Unit mu; if (!StaticOrder::next(i / 3, mu)) return false; u.pm = mu.pm; u.pn = mu.pn + 4 * (i % 3); return true; }
};
template <bool GATH> struct MoeOrder : StaticOrder {
    static constexpr bool GATHER = GATH;
    const int* tile_exp; const int* rowtok; size_t estride;
    __device__ __forceinline__ size_t b_off(const Unit& u, size_t tstep) const { return (size_t)tile_exp[u.pm] * estride + (size_t)u.pn * tstep; }
    __device__ __forceinline__ int b_key(const Unit& u) const { return tile_exp[u.pm]; }
    __device__ __forceinline__ size_t b_off_k(int key, const Unit& u, size_t tstep) const { return (size_t)key * estride + (size_t)u.pn * tstep; }
    __device__ __forceinline__ int row(const Unit& u, int r) const { return rowtok[u.pm * BM + r]; }
    unsigned* cnt; unsigned* tmo;
    __device__ __forceinline__ void done(const Unit& u) const {
        if (GATH) { asm volatile("s_waitcnt vmcnt(0)" ::: "memory"); if ((threadIdx.x & 63) == 0) __hip_atomic_fetch_add(cnt + 64 * u.pm, 1u, __ATOMIC_RELAXED, __HIP_MEMORY_SCOPE_AGENT); }
    }
    __device__ __forceinline__ void a_ready(const Unit& u) const {
        if (!GATH) {
            if (threadIdx.x < 64) {
                unsigned polls = 0;
                while ((unsigned)__builtin_amdgcn_readfirstlane(__hip_atomic_load(cnt + 64 * u.pm, __ATOMIC_RELAXED, __HIP_MEMORY_SCOPE_AGENT)) < 32u) {
                    ++polls;
                    if ((polls & 255u) == 0u && __builtin_amdgcn_readfirstlane(__hip_atomic_load(tmo, __ATOMIC_RELAXED, __HIP_MEMORY_SCOPE_AGENT)) != 0u) break;
                    if (polls > 100000u) { if (threadIdx.x == 0) __hip_atomic_store(tmo, 1u, __ATOMIC_RELAXED, __HIP_MEMORY_SCOPE_AGENT); break; }
                    __builtin_amdgcn_s_sleep(2); }
                __builtin_amdgcn_fence(__ATOMIC_ACQUIRE, "agent");
                asm volatile("s_waitcnt vmcnt(0)" ::: "memory");
            }
            asm volatile("" ::: "memory"); __builtin_amdgcn_s_barrier(); asm volatile("" ::: "memory");
        }
    }
    __device__ bool next(int i, Unit& u) const {
        if (GATH) return StaticOrder::next(i, u);
        const int U = nwg, R = U % G, q = U / G, x = (R > 0 && q > 3) ? q - 3 : (R > 0 ? 0 : 0); long j;
        if (c < R) { if (i >= x) return false; j = (long)U - (long)R * x + c + (long)i * R; }
        else { j = (long)(c - R) + (long)i * (G - R); if (j >= (long)U - (long)R * x) return false; }
        unit_of(j, u); return true;
    }
};

typedef f32x4 Acc[2][2][4][2];

__device__ __forceinline__ const char* uni_ptr(const char* p) { const unsigned long long v = (unsigned long long)p; const unsigned lo = __builtin_amdgcn_readfirstlane((unsigned)v), hi = __builtin_amdgcn_readfirstlane((unsigned)(v >> 32)); return (const char*)(((unsigned long long)hi << 32) | lo); }
template <class Epi, class Sched, bool ALIGN_EPI, int QM = 0>
__device__ __forceinline__ void gemm_phase(LAS unsigned char* lds, const Gemm g, const Sched& S, const Epi& E) {
    constexpr bool GATHER = Sched::GATHER, FP8 = QM == 1, I8 = QM == 2; static_assert(!I8 || Epi::PERM, "int8 flavour: PERM column map");
    int tid = threadIdx.x; asm volatile("" : "+v"(tid));
    const int wid = __builtin_amdgcn_readfirstlane(tid >> 6), lane = tid & 63, wr = wid >> 2, wc = wid & 3, fr = lane & 15, fq = lane >> 4;
    const int K = g.K, nt = K / BK;
    unsigned voffB[2]; int Rr[2], Cc[2];
#pragma unroll
    for (int i = 0; i < 2; ++i) { int R, C; stage_rc(tid * 16 + i * 8192, R, C); Rr[i] = R; Cc[i] = C; const int Rb = Epi::PERM ? ((R & ~31) + perm32(R & 31)) : R;
        voffB[i] = (unsigned)(Rb * K + C) * 2u; }
    const size_t kstep = (size_t)(BK * 2);
    const size_t hstep = (size_t)HALF * K * 2;
    const size_t tstep = 2 * hstep;
    const unsigned ldsw = (unsigned)wid * 1024u;
    const int aoff = lds_byte(wr * 64 + fr, fq * 8), boff = lds_byte(wc * 32 + fr, fq * 8);
#define PG8_SA(b, h) (((b) * 2 + (h)) * HTB)
#define PG8_SB(b, h) ((4 + (b) * 2 + (h)) * HTB)
#define PG8_STAGE(bufoff, gbase, voff) do { _Pragma("unroll") for (int _i = 0; _i < 2; ++_i) \
        __builtin_amdgcn_global_load_lds((const unsigned*)((const char*)(gbase) + (voff)[_i]), (LAS unsigned*)(lds + (bufoff) + ldsw + _i * 8192), 16, 0, 0); } while (0)
#define PG8_STAGEA(bufoff, gbase, v, h) do { _Pragma("unroll") for (int _i = 0; _i < 2; ++_i) \
        __builtin_amdgcn_global_load_lds((const unsigned*)((const char*)(gbase) + (v)[h][_i]), (LAS unsigned*)(lds + (bufoff) + ldsw + _i * 8192), 16, 0, 0); } while (0)
#define PG8_SETA(v, u) do { _Pragma("unroll") for (int _h = 0; _h < 2; ++_h) _Pragma("unroll") for (int _i = 0; _i < 2; ++_i) \
        (v)[_h][_i] = GATHER ? (unsigned)(S.row((u), _h * HALF + Rr[_i]) * K + Cc[_i]) * 2u : (unsigned)((_h * HALF + Rr[_i]) * K + Cc[_i]) * 2u; \
        asm volatile("" : "+v"((v)[0][0]), "+v"((v)[0][1]), "+v"((v)[1][0]), "+v"((v)[1][1])); } while (0)
    typedef int v8i_ __attribute__((ext_vector_type(8))); typedef int v4i_ __attribute__((ext_vector_type(4)));
#define PG8_LD2(p_) (__builtin_shufflevector(*(const LAS v4i_*)(p_), *(const LAS v4i_*)((p_) + 1024), 0, 1, 2, 3, 4, 5, 6, 7))
#define PG8_LDA(dst, b, h) do { _Pragma("unroll") for (int m = 0; m < 4; ++m) { if constexpr (FP8) dst##8[m] = PG8_LD2(lds + PG8_SA(b, h) + aoff + m * 2048); else { _Pragma("unroll") for (int k = 0; k < 2; ++k) dst[m][k] = *(const LAS bf16x8*)(lds + PG8_SA(b, h) + aoff + m * 2048 + k * 1024); } } } while (0)
#define PG8_LDB(dst, b, h) do { _Pragma("unroll") for (int n = 0; n < 2; ++n) { if constexpr (FP8) dst##8[n] = PG8_LD2(lds + PG8_SB(b, h) + boff + n * 2048); else { _Pragma("unroll") for (int k = 0; k < 2; ++k) dst[n][k] = *(const LAS bf16x8*)(lds + PG8_SB(b, h) + boff + n * 2048 + k * 1024); } } } while (0)
#define PG8_MMA(ai, bj, At, Bt) do { __builtin_amdgcn_s_setprio(1); _Pragma("unroll") for (int m = 0; m < 4; ++m) _Pragma("unroll") for (int n = 0; n < 2; ++n) { \
        if constexpr (FP8) { asm volatile("v_mfma_scale_f32_16x16x128_f8f6f4 %0, %1, %2, %0, %3, %3 op_sel_hi:[0,0,0]" : "+v"(acc[ai][bj][m][n]) : "v"(Bt##8[n]), "v"(At##8[m]), "v"(mx_one)); } \
        else if constexpr (I8) { _Pragma("unroll") for (int k = 0; k < 2; ++k) acc[ai][bj][m][n] = __builtin_bit_cast(f32x4, __builtin_amdgcn_mfma_i32_16x16x64_i8(__builtin_bit_cast(v4i_, Bt[n][k]), __builtin_bit_cast(v4i_, At[m][k]), __builtin_bit_cast(v4i_, acc[ai][bj][m][n]), 0, 0, 0)); } \
        else { _Pragma("unroll") for (int k = 0; k < 2; ++k) acc[ai][bj][m][n] = __builtin_amdgcn_mfma_f32_16x16x32_bf16(Bt[n][k], At[m][k], acc[ai][bj][m][n], 0, 0, 0); } } \
        __builtin_amdgcn_s_setprio(0); } while (0)
#define PG8_WAIT_V(n) asm volatile("s_waitcnt vmcnt(" #n ")" ::: "memory")
#define PG8_WAIT_L(n) asm volatile("s_waitcnt lgkmcnt(" #n ")" ::: "memory")
#define PG8_BAR __builtin_amdgcn_s_barrier()
#define PG8_SCHED __builtin_amdgcn_sched_barrier(0)
    Unit cur, nxt; int ui = 0;
    if (!S.next(0, cur)) return;
    Acc acc;
#pragma unroll
    for (int a = 0; a < 2; ++a)
#pragma unroll
        for (int b = 0; b < 2; ++b)
#pragma unroll
            for (int m = 0; m < 4; ++m)
#pragma unroll
                for (int n = 0; n < 2; ++n) acc[a][b][m][n] = (f32x4){0.f, 0.f, 0.f, 0.f};
    bf16x8 At[4][2], B0[2][2], B1[2][2]; v8i_ At8[4], B08[2], B18[2];
    int mx_one = 0x7f7f7f7f; asm volatile("" : "+v"(mx_one));
    unsigned vA[2][2], vN[2][2];
    S.a_ready(cur);
    PG8_SETA(vA, cur);
    const char* cA = (const char*)g.A + (GATHER ? (size_t)0 : (size_t)cur.pm * tstep); const char* cB = (const char*)g.Bt + S.b_off(cur, tstep);
    PG8_STAGE(PG8_SB(0, 0), cB, voffB); PG8_STAGE(PG8_SB(0, 1), cB + hstep, voffB); PG8_STAGEA(PG8_SA(0, 0), cA, vA, 0); PG8_STAGEA(PG8_SA(0, 1), cA, vA, 1);
    if (wr == 1) PG8_BAR;
    PG8_WAIT_V(2); PG8_BAR;
    PG8_STAGE(PG8_SB(1, 0), cB + kstep, voffB); PG8_STAGEA(PG8_SA(1, 0), cA + kstep, vA, 0); PG8_STAGE(PG8_SB(1, 1), cB + hstep + kstep, voffB);
    PG8_WAIT_V(6); PG8_BAR;
    for (;;) {
        const bool has_next = S.next(ui + 1, nxt);
        const char* nA = has_next ? (const char*)g.A + (GATHER ? (size_t)0 : (size_t)nxt.pm * tstep) : cA; const char* nB = cB;
        int keyN = 0;
        if (has_next) { keyN = S.b_key(nxt);
            if (GATHER) {
#pragma unroll
                for (int h = 0; h < 2; ++h)
#pragma unroll
                    for (int i = 0; i < 2; ++i) vN[h][i] = (unsigned)S.row(nxt, h * HALF + Rr[i]); } }
#pragma unroll 1
        for (int t = 0; t < nt; t += 2) {
            const bool last = (t == nt - 2);
            if constexpr (Epi::MIDK) { if (t == Epi::MID1 || t == Epi::MID2) E.mid(acc, cur, t, wr, wc, fr, fq); }
            const char* a1 = cA + (size_t)(t + 1) * kstep;
            if (last) {
                if (has_next) S.a_ready(nxt);
                if (has_next) nB = (const char*)g.Bt + S.b_off_k(__builtin_amdgcn_readfirstlane(keyN), nxt, tstep);
                if (GATHER) {
                    if (has_next) { asm volatile("" : "+v"(vN[0][0]), "+v"(vN[0][1]), "+v"(vN[1][0]), "+v"(vN[1][1])); }
#pragma unroll
                    for (int h = 0; h < 2; ++h)
#pragma unroll
                        for (int i = 0; i < 2; ++i) vN[h][i] = has_next ? (unsigned)((int)vN[h][i] * K + Cc[i]) * 2u : vA[h][i]; }
            }
            const char* a2 = last ? nA : cA + (size_t)(t + 2) * kstep; const char* b2 = last ? nB : cB + (size_t)(t + 2) * kstep;
            const char* a3 = a2 + kstep; const char* b3 = b2 + kstep;
            unsigned w2[2][2];
#pragma unroll
            for (int h = 0; h < 2; ++h)
#pragma unroll
                for (int i = 0; i < 2; ++i) w2[h][i] = (GATHER && last) ? vN[h][i] : vA[h][i];
            PG8_LDB(B0, 0, 0); PG8_LDB(B1, 0, 1); PG8_SCHED; PG8_LDA(At, 0, 0); PG8_STAGEA(PG8_SA(1, 1), a1, vA, 1);
            PG8_WAIT_V(8); PG8_WAIT_L(0); PG8_BAR; PG8_MMA(0, 0, At, B0); PG8_MMA(0, 1, At, B1); PG8_BAR; PG8_SCHED;
            PG8_LDA(At, 0, 1); PG8_STAGE(PG8_SB(0, 0), b2, voffB); PG8_STAGE(PG8_SB(0, 1), b2 + hstep, voffB); PG8_STAGEA(PG8_SA(0, 0), a2, w2, 0);
            PG8_WAIT_V(8); PG8_WAIT_L(0); PG8_BAR; PG8_MMA(1, 0, At, B0); PG8_MMA(1, 1, At, B1); PG8_BAR; PG8_SCHED;
            PG8_LDB(B0, 1, 0); PG8_LDB(B1, 1, 1); PG8_SCHED; PG8_LDA(At, 1, 0); PG8_STAGEA(PG8_SA(0, 1), a2, w2, 1);
            PG8_WAIT_V(8); PG8_WAIT_L(0); PG8_BAR; PG8_MMA(0, 0, At, B0); PG8_MMA(0, 1, At, B1); PG8_BAR; PG8_SCHED;
            PG8_LDA(At, 1, 1); PG8_STAGE(PG8_SB(1, 0), b3, voffB); PG8_STAGE(PG8_SB(1, 1), b3 + hstep, voffB); PG8_STAGEA(PG8_SA(1, 0), a3, w2, 0);
            PG8_WAIT_V(8); PG8_WAIT_L(0); PG8_BAR; PG8_MMA(1, 0, At, B0); PG8_MMA(1, 1, At, B1); PG8_BAR; PG8_SCHED;
        }
        if constexpr (ALIGN_EPI) { if (wr == 0) PG8_BAR; }
        if constexpr (FP8) asm volatile("s_nop 15\n\ts_nop 15\n\ts_nop 7" ::: "memory");
        if constexpr (I8) {
#pragma unroll
            for (int bj = 0; bj < 2; ++bj)
#pragma unroll
                for (int n = 0; n < 2; ++n) { const f32x4 c = *(const f32x4*)(g.cs + cur.pn * BM + bj * HALF + wc * 32 + 8 * fq + 4 * n);
#pragma unroll
                    for (int ai = 0; ai < 2; ++ai)
#pragma unroll
                        for (int m = 0; m < 4; ++m)
#pragma unroll
                            for (int j = 0; j < 4; ++j) acc[ai][bj][m][n][j] = (float)__float_as_int(acc[ai][bj][m][n][j]) * c[j]; } }
        E(acc, cur, wr, wc, fr, fq); S.done(cur);
        if (!has_next) break;
#pragma unroll
        for (int a = 0; a < 2; ++a)
#pragma unroll
            for (int b = 0; b < 2; ++b)
#pragma unroll
                for (int m = 0; m < 4; ++m)
#pragma unroll
                    for (int n = 0; n < 2; ++n) acc[a][b][m][n] = (f32x4){0.f, 0.f, 0.f, 0.f};
        cur = nxt; cA = nA; cB = nB; ++ui;
        if (GATHER) {
#pragma unroll
            for (int h = 0; h < 2; ++h)
#pragma unroll
                for (int i = 0; i < 2; ++i) vA[h][i] = vN[h][i]; }
        if constexpr (ALIGN_EPI) { if (wr == 1) PG8_BAR; }
    }
    PG8_WAIT_V(0);
    if constexpr (!ALIGN_EPI) { if (wr == 0) PG8_BAR; }
    PG8_BAR;
#undef PG8_SA
#undef PG8_SB
#undef PG8_STAGE
#undef PG8_STAGEA
#undef PG8_SETA
#undef PG8_LDA
#undef PG8_LD2
#undef PG8_LDB
#undef PG8_MMA
#undef PG8_WAIT_V
#undef PG8_WAIT_L
#undef PG8_BAR
#undef PG8_SCHED
}

__device__ __forceinline__ u32x4 pack8(const f32x4& a, const f32x4& b) { u32x4 w; w.x = cvt_pk_bf16(a[0], a[1]); w.y = cvt_pk_bf16(a[2], a[3]); w.z = cvt_pk_bf16(b[0], b[1]); w.w = cvt_pk_bf16(b[2], b[3]); return w; }

struct EpiMix {
    static constexpr bool PERM = true, MIDK = false; static constexpr int MID1 = -1, MID2 = -1;
    bf16_t* pb; _Float16* logf; const float* rs; const float* lb; float qscale, cqscale; unsigned* kmt;
    __device__ __forceinline__ void operator()(const Acc& acc, const Unit& u, int wr, int wc, int fr, int fq) const {
        float kmx[2][2] = {{0.f, 0.f}, {0.f, 0.f}};
        const int type = u.pn >> 1; const int colb = (u.pn & 1) * 256 + wc * 32 + 8 * fq;
        int slot = 0; float sc = 1.f;
        switch (type) { case 0: slot = SL_QA; sc = qscale; break; case 1: slot = SL_KA; break; case 2: slot = SL_VA; break; case 3: slot = SL_HQ; break;
                        case 5: slot = SL_HV; break; case 6: slot = SL_HG; break; case 7: slot = SL_CQ; sc = cqscale; break; default: break; }
        bf16_t* ob = pb + (size_t)slot * HT * 512;
        float rv[2][4];
#pragma unroll
        for (int ai = 0; ai < 2; ++ai)
#pragma unroll
            for (int m = 0; m < 4; ++m) rv[ai][m] = rs[u.pm * BM + ai * HALF + wr * 64 + m * 16 + fr];
        f32x4 lbv[2][2] = {{(f32x4){0.f, 0.f, 0.f, 0.f}, (f32x4){0.f, 0.f, 0.f, 0.f}}, {(f32x4){0.f, 0.f, 0.f, 0.f}, (f32x4){0.f, 0.f, 0.f, 0.f}}};
        if (type == 4) {
#pragma unroll
            for (int bj = 0; bj < 2; ++bj) { lbv[bj][0] = *(const f32x4*)(lb + colb + bj * HALF); lbv[bj][1] = *(const f32x4*)(lb + colb + bj * HALF + 4); } }
#pragma unroll
        for (int ai = 0; ai < 2; ++ai)
#pragma unroll
            for (int m = 0; m < 4; ++m) {
                const int row = u.pm * BM + ai * HALF + wr * 64 + m * 16 + fr; const float r = rv[ai][m];
#pragma unroll
                for (int bj = 0; bj < 2; ++bj) {
                    const int col = colb + bj * HALF;
                    f32x4 v0 = acc[ai][bj][m][0] * r, v1 = acc[ai][bj][m][1] * r;
                    if (type == 4) {
                        const f32x4 l0 = lbv[bj][0], l1 = lbv[bj][1];
#pragma unroll
                        for (int j = 0; j < 4; ++j) { v0[j] = __logf(l0[j] + (1.f - l0[j]) * fsigmoid(v0[j])); v1[j] = __logf(l1[j] + (1.f - l1[j]) * fsigmoid(v1[j])); }
                        typedef _Float16 h16x8 __attribute__((ext_vector_type(8))); h16x8 hv_;
#pragma unroll
                        for (int j = 0; j < 4; ++j) { hv_[j] = (_Float16)v0[j]; hv_[4 + j] = (_Float16)v1[j]; }
                        *(h16x8*)(logf + (size_t)row * 512 + col) = hv_;
                    } else {
                        if (type == 3 || type == 6) {
#pragma unroll
                            for (int j = 0; j < 4; ++j) { v0[j] = fsilu(v0[j]); v1[j] = fsilu(v1[j]); }
                        } else { v0 = v0 * sc; v1 = v1 * sc; }
                        const u32x4 w8 = pack8(v0, v1);
                        *(u32x4*)(ob + (size_t)row * 512 + col) = w8;
                        if (type == 1) {
                            float a = 0.f;
#pragma unroll
                            for (int e = 0; e < 4; ++e) { const float lo = __uint_as_float(w8[e] << 16), hi = __uint_as_float(w8[e] & 0xffff0000u); a += lo * lo + hi * hi; }
                            a += __shfl_xor(a, 16); a += __shfl_xor(a, 32);
                            kmx[ai][bj] = fmaxf(kmx[ai][bj], a);
                        }
                    }
                }
            }
        if (type == 1) {
#pragma unroll
            for (int ai = 0; ai < 2; ++ai)
#pragma unroll
                for (int bj = 0; bj < 2; ++bj) { float a = kmx[ai][bj];
#pragma unroll
                    for (int o = 1; o < 16; o <<= 1) a = fmaxf(a, __shfl_xor(a, o));
                    if (fr == 0 && fq == 0) { const int tok = u.pm * BM + ai * HALF + wr * 64, bl = tok >> 12, tile = (tok & 4095) >> 6, h = 2 * (u.pn & 1) + bj;
                        __hip_atomic_fetch_max(kmt + ((((bl * 4 + h) * 2 + (wc >> 1)) * 64 + tile) * 2 + (wc & 1)), __float_as_uint(a), __ATOMIC_RELAXED, __HIP_MEMORY_SCOPE_AGENT); } }
        }
    }
};
struct EpiRowFp8 {
    static constexpr bool PERM = true, MIDK = false; static constexpr int MID1 = -1, MID2 = -1;
    unsigned char* O; float cs;
    __device__ __forceinline__ void operator()(const Acc& acc, const Unit& u, int wr, int wc, int fr, int fq) const {
        const int colb = u.pn * BM + wc * 32 + 8 * fq;
#pragma unroll
        for (int ai = 0; ai < 2; ++ai)
#pragma unroll
            for (int m = 0; m < 4; ++m) {
                const int row = u.pm * BM + ai * HALF + wr * 64 + m * 16 + fr;
#pragma unroll
                for (int bj = 0; bj < 2; ++bj) {
                    const f32x4 v0 = acc[ai][bj][m][0] * cs, v1 = acc[ai][bj][m][1] * cs; u32x2 w; w.x = pk4_fp8(v0[0], v0[1], v0[2], v0[3]); w.y = pk4_fp8(v1[0], v1[1], v1[2], v1[3]);
                    *(u32x2*)(O + (size_t)row * 1024 + colb + bj * HALF) = w;
                }
            }
    }
};
template <int ACT> struct EpiRowBf16 {
    static constexpr bool PERM = true, MIDK = false; static constexpr int MID1 = -1, MID2 = -1;
    bf16_t* O; int ldc; const float* rs; float cs;
    __device__ __forceinline__ void operator()(const Acc& acc, const Unit& u, int wr, int wc, int fr, int fq) const {
        const int colb = u.pn * BM + wc * 32 + 8 * fq;
        float rv[2][4];
#pragma unroll
        for (int ai = 0; ai < 2; ++ai)
#pragma unroll
            for (int m = 0; m < 4; ++m) rv[ai][m] = rs ? rs[u.pm * BM + ai * HALF + wr * 64 + m * 16 + fr] : 1.f;
#pragma unroll
        for (int ai = 0; ai < 2; ++ai)
#pragma unroll
            for (int m = 0; m < 4; ++m) {
                const int row = u.pm * BM + ai * HALF + wr * 64 + m * 16 + fr; const float r = rv[ai][m];
#pragma unroll
                for (int bj = 0; bj < 2; ++bj) {
                    f32x4 v0 = acc[ai][bj][m][0] * (r * cs), v1 = acc[ai][bj][m][1] * (r * cs);
                    if (ACT == 1) {
#pragma unroll
                        for (int j = 0; j < 4; ++j) { v0[j] = fsigmoid(v0[j]); v1[j] = fsigmoid(v1[j]); } }
                    *(u32x4*)(O + (size_t)row * ldc + colb + bj * HALF) = pack8(v0, v1);
                }
            }
    }
};
struct EpiGatesNative {
    static constexpr bool PERM = true, MIDK = false; static constexpr int MID1 = -1, MID2 = -1;
    unsigned char* G; const float* rs;
    __device__ __forceinline__ void operator()(const Acc& acc, const Unit& u, int wr, int wc, int fr, int fq) const {
        float rv[2][4];
#pragma unroll
        for (int ai = 0; ai < 2; ++ai)
#pragma unroll
            for (int m = 0; m < 4; ++m) rv[ai][m] = rs[u.pm * BM + ai * HALF + wr * 64 + m * 16 + fr];
        unsigned char* gt = G + (size_t)((u.pm * 12 + u.pn) * 8 + wr * 4 + wc) * 8192 + (fq * 16 + fr) * 16;
#pragma unroll
        for (int ai = 0; ai < 2; ++ai)
#pragma unroll
            for (int m = 0; m < 4; ++m) { u32x4 o;
#pragma unroll
                for (int bj = 0; bj < 2; ++bj)
#pragma unroll
                    for (int n = 0; n < 2; ++n) { const f32x4 v = acc[ai][bj][m][n] * rv[ai][m]; unsigned w = 0;
#pragma unroll
                        for (int j = 0; j < 4; ++j) w = __builtin_amdgcn_cvt_pk_u8_f32(fmaxf(255.f * fsigmoid(v[j]), 1.f), j, w);
                        o[bj * 2 + n] = w; }
                *(u32x4*)(gt + (ai * 4 + m) * 1024) = o; }
    }
};
struct EpiMerge {
    static constexpr bool PERM = true, MIDK = true; static constexpr int MID1 = 8, MID2 = 16;
    const unsigned char* gates; bf16_t* O;
    __device__ __forceinline__ void mid(Acc& acc, const Unit& u, int t, int wr, int wc, int fr, int fq) const {
        const int i = (t == MID1) ? 0 : 1;
        const unsigned char* gp0 = gates + (size_t)((u.pm * 12 + i * 4 + u.pn) * 8 + wr * 4 + wc) * 8192 + (fq * 16 + fr) * 16;
        u32x4 av[8], bv[8];
#pragma unroll
        for (int g = 0; g < 8; ++g) { av[g] = *(const u32x4*)(gp0 + g * 1024); bv[g] = *(const u32x4*)(gp0 + g * 1024 + (size_t)4 * 8 * 8192); }
        __builtin_amdgcn_sched_barrier(0);
#pragma unroll
        for (int ai = 0; ai < 2; ++ai)
#pragma unroll
            for (int m = 0; m < 4; ++m) { const u32x4 a = av[ai * 4 + m], b = bv[ai * 4 + m];
#pragma unroll
                for (int bj = 0; bj < 2; ++bj)
#pragma unroll
                    for (int n = 0; n < 2; ++n)
#pragma unroll
                        for (int e = 0; e < 4; ++e) acc[ai][bj][m][n][e] *= (float)((a[bj * 2 + n] >> (8 * e)) & 255u) * __builtin_amdgcn_rcpf((float)((b[bj * 2 + n] >> (8 * e)) & 255u));
            }
    }
    __device__ __forceinline__ void operator()(const Acc& acc, const Unit& u, int wr, int wc, int fr, int fq) const {
        const int colb = u.pn * BM + wc * 32 + 8 * fq;
#pragma unroll
        for (int ai = 0; ai < 2; ++ai) {
            u32x4 av[4];
#pragma unroll
            for (int m = 0; m < 4; ++m) av[m] = *(const u32x4*)(gates + (size_t)((u.pm * 12 + 8 + u.pn) * 8 + wr * 4 + wc) * 8192 + (ai * 4 + m) * 1024 + (fq * 16 + fr) * 16);
            __builtin_amdgcn_sched_barrier(0);
#pragma unroll
            for (int m = 0; m < 4; ++m) {
                const int row = u.pm * BM + ai * HALF + wr * 64 + m * 16 + fr; const u32x4 a = av[m];
#pragma unroll
                for (int bj = 0; bj < 2; ++bj) {
                    f32x4 v0 = acc[ai][bj][m][0], v1 = acc[ai][bj][m][1];
#pragma unroll
                    for (int e = 0; e < 4; ++e) { v0[e] *= (float)((a[bj * 2] >> (8 * e)) & 255u) * (1.f / 255.f); v1[e] *= (float)((a[bj * 2 + 1] >> (8 * e)) & 255u) * (1.f / 255.f); }
                    *(u32x4*)(O + (size_t)row * 1024 + colb + bj * HALF) = pack8(v0, v1);
                }
            }
        }
    }
};
struct EpiOut {
    static constexpr bool PERM = true, MIDK = false; static constexpr int MID1 = -1, MID2 = -1;
    bf16_t* xb; unsigned char* xb8;
    __device__ __forceinline__ void operator()(const Acc& acc, const Unit& u, int wr, int wc, int fr, int fq) const {
        const int colb = u.pn * BM + wc * 32 + 8 * fq;
#pragma unroll
        for (int ai = 0; ai < 2; ++ai) {
            u32x4 xo[4][2];
#pragma unroll
            for (int m = 0; m < 4; ++m)
#pragma unroll
                for (int bj = 0; bj < 2; ++bj) xo[m][bj] = *(const u32x4*)(xb + (size_t)(u.pm * BM + ai * HALF + wr * 64 + m * 16 + fr) * D + colb + bj * HALF);
            __builtin_amdgcn_sched_barrier(0);
#pragma unroll
            for (int m = 0; m < 4; ++m)
#pragma unroll
                for (int bj = 0; bj < 2; ++bj) {
                    const size_t o = (size_t)(u.pm * BM + ai * HALF + wr * 64 + m * 16 + fr) * D + colb + bj * HALF; const u32x4 b = xo[m][bj];
                    const f32x4 v0 = (f32x4){__uint_as_float(b.x << 16), __uint_as_float(b.x & 0xffff0000u), __uint_as_float(b.y << 16), __uint_as_float(b.y & 0xffff0000u)} + acc[ai][bj][m][0];
                    const f32x4 v1 = (f32x4){__uint_as_float(b.z << 16), __uint_as_float(b.z & 0xffff0000u), __uint_as_float(b.w << 16), __uint_as_float(b.w & 0xffff0000u)} + acc[ai][bj][m][1];
                    *(u32x4*)(xb + o) = pack8(v0, v1);
                    u32x2 w8; w8.x = pk4_fp8(v0[0], v0[1], v0[2], v0[3]); w8.y = pk4_fp8(v1[0], v1[1], v1[2], v1[3]); *(u32x2*)(xb8 + o) = w8;
                }
        }
    }
};

struct EpiGateUp {
    static constexpr bool PERM = true, MIDK = false; static constexpr int MID1 = -1, MID2 = -1;
    unsigned char* act; const float* rowrs; const float* rowwt;
    __device__ __forceinline__ void operator()(const Acc& acc, const Unit& u, int wr, int wc, int fr, int fq) const {
        const int colb = u.pn * 128 + wc * 16 + 4 * fq;
        float rv[2][4], wv[2][4];
#pragma unroll
        for (int ai = 0; ai < 2; ++ai)
#pragma unroll
            for (int m = 0; m < 4; ++m) { const int row = u.pm * BM + ai * HALF + wr * 64 + m * 16 + fr; rv[ai][m] = rowrs[row]; wv[ai][m] = rowwt[row]; }
#pragma unroll
        for (int ai = 0; ai < 2; ++ai)
#pragma unroll
            for (int m = 0; m < 4; ++m) {
                const int row = u.pm * BM + ai * HALF + wr * 64 + m * 16 + fr; const float r = rv[ai][m] * (1.f / W8_SCALE), w = wv[ai][m] * ACT8_SCALE;
#pragma unroll
                for (int bj = 0; bj < 2; ++bj) {
                    const f32x4 gt = acc[ai][bj][m][0] * r, up = acc[ai][bj][m][1] * r; f32x4 a;
#pragma unroll
                    for (int j = 0; j < 4; ++j) a[j] = fsilu(gt[j]) * up[j] * w;
                    __hip_atomic_store((unsigned*)(act + (size_t)row * DE + colb + bj * 64), pk4_fp8(a[0], a[1], a[2], a[3]), __ATOMIC_RELAXED, __HIP_MEMORY_SCOPE_AGENT);
                }
                __builtin_amdgcn_sched_barrier(0);
            }
    }
};
}

constexpr int LDS_BYTES = 147456;
constexpr int NTHREADS = 512;

__device__ __forceinline__ void setup_phase(const Params& p, int b0, int nb) {
    unsigned char* ws = p.ws; const int tid = threadIdx.x;
    float* lam = (float*)(ws + WS_LAM); float* lbs = (float*)(ws + WS_LBS); float* wrt = (float*)(ws + WS_WRT);
    if (b0 == 0) {
        if (tid < 128) {
            const int l = tid >> 6, lane = tid & 63; const float* lp = p.in[4] + l * 256;
            const float a = wave_sum(lp[lane] * lp[64 + lane]), b = wave_sum(lp[128 + lane] * lp[192 + lane]);
            const float lam_init = 0.8f - 0.6f * expf(-0.3f * (float)l);
            if (lane == 0) lam[l] = expf(a) - expf(b) + lam_init;
        }
        { const int i = tid; const float v0 = p.in[6][i], v1 = p.in[6][512 + i]; const float m = fmaxf(v0, v1); const float e0 = expf(v0 - m), e1 = expf(v1 - m);
            lbs[i] = 0.f; lbs[512 + i] = e1 / (e0 + e1); }
    }
    for (int i = b0 * 512 + tid; i < 2 * 1024 * 16; i += nb * 512) { const int l = i >> 14, ii = i & 3, e = (i >> 2) & 15, qd = (i >> 6) & 3, sidx = (i >> 8) & 63; const int k = 16 * sidx + 4 * qd + ii; wrt[i] = p.in[12][l * 1024 + k] * p.in[13][k * 16 + e]; }
}

__device__ __forceinline__ void convert_tile(const float* src, int ldsrc, const float* gain, bf16_t* dst, int Kdst, int k_off, int mode, int kt, int ntile, LAS float* tile) {
    int tid = threadIdx.x; asm volatile("" : "+v"(tid));
    { const int n = tid & 255, k0 = tid >> 8; float v[32];
      const float* sp = src + (size_t)(kt * 64 + k0) * ldsrc + ntile * 256 + n;
#pragma unroll
      for (int j = 0; j < 32; ++j) v[j] = sp[(size_t)(2 * j) * ldsrc];
      __builtin_amdgcn_sched_barrier(0);
#pragma unroll
      for (int j = 0; j < 32; ++j) { const int k = k0 + 2 * j; const float gk = gain ? gain[kt * 64 + k] : 1.f; tile[k * 257 + n] = v[j] * gk; } }
    __syncthreads();
    { const int c = tid & 7;
#pragma unroll
      for (int i = 0; i < 4; ++i) { const int n = (tid >> 3) + 64 * i; const LAS float* sl = tile + (8 * c) * 257 + n;
          u32x4 o; o.x = pk2(sl[0], sl[257]); o.y = pk2(sl[514], sl[771]); o.z = pk2(sl[1028], sl[1285]); o.w = pk2(sl[1542], sl[1799]);
          const int ng = ntile * 256 + n; const int row = mode == 0 ? ng : (8 * (ng >> 2) + (ng & 3) + (mode == 2 ? 4 : 0));
          *(u32x4*)(dst + (size_t)row * Kdst + k_off + kt * 64 + 8 * c) = o; } }
    __syncthreads();
}
__device__ __forceinline__ void convert_tile8(const float* src, int ldsrc, const float* gain, unsigned char* dst, int Kdst, int mode, int kt, int ntile, LAS float* tile) {
    int tid = threadIdx.x; asm volatile("" : "+v"(tid));
    { const int n = tid & 255, k0 = tid >> 8; float v[32];
      const float* sp = src + (size_t)(kt * 64 + k0) * ldsrc + ntile * 256 + n;
#pragma unroll
      for (int j = 0; j < 32; ++j) v[j] = sp[(size_t)(2 * j) * ldsrc];
      __builtin_amdgcn_sched_barrier(0);
#pragma unroll
      for (int j = 0; j < 32; ++j) { const int k = k0 + 2 * j; const float gk = (gain ? gain[kt * 64 + k] : 1.f) * W8_SCALE; tile[k * 257 + n] = v[j] * gk; } }
    __syncthreads();
    { const int c = tid & 3;
#pragma unroll
      for (int i = 0; i < 2; ++i) { const int n = (tid >> 2) + 128 * i; const LAS float* sl = tile + (16 * c) * 257 + n;
          u32x4 o; o.x = pk4_fp8(sl[0], sl[257], sl[514], sl[771]); o.y = pk4_fp8(sl[1028], sl[1285], sl[1542], sl[1799]); o.z = pk4_fp8(sl[2056], sl[2313], sl[2570], sl[2827]); o.w = pk4_fp8(sl[3084], sl[3341], sl[3598], sl[3855]);
          const int ng = ntile * 256 + n; const int row = mode == 0 ? ng : (8 * (ng >> 2) + (ng & 3) + (mode == 2 ? 4 : 0));
          *(u32x4*)(dst + (size_t)row * Kdst + kt * 64 + 16 * c) = o; } }
    __syncthreads();
}
__device__ __forceinline__ void convert_tile_i8(const float* src, int ldsrc, const float* gain, const unsigned* wmax, float* wsc, unsigned char* dst, int kt, int ntile, LAS float* tile) {
    int tid = threadIdx.x; asm volatile("" : "+v"(tid));
    { const int n = tid & 255, k0 = tid >> 8; float v[32];
      const float* sp = src + (size_t)(kt * 64 + k0) * ldsrc + ntile * 256 + n;
#pragma unroll
      for (int j = 0; j < 32; ++j) v[j] = sp[(size_t)(2 * j) * ldsrc];
      const float am = fmaxf(__uint_as_float(wmax[ntile * 256 + n]), 1e-30f), inv = 127.f / am;
      if (kt == 0 && k0 == 0) wsc[ntile * 256 + n] = am * (1.f / 127.f);
      __builtin_amdgcn_sched_barrier(0);
#pragma unroll
      for (int j = 0; j < 32; ++j) { const int k = k0 + 2 * j; const float gk = gain[kt * 64 + k]; tile[k * 257 + n] = (v[j] * gk) * inv; } }
    __syncthreads();
    { const int c = tid & 3;
#pragma unroll
      for (int i = 0; i < 2; ++i) { const int n = (tid >> 2) + 128 * i; const LAS float* sl = tile + (16 * c) * 257 + n;
          u32x4 o; o.x = pk4_i8(sl[0], sl[257], sl[514], sl[771]); o.y = pk4_i8(sl[1028], sl[1285], sl[1542], sl[1799]); o.z = pk4_i8(sl[2056], sl[2313], sl[2570], sl[2827]); o.w = pk4_i8(sl[3084], sl[3341], sl[3598], sl[3855]);
          *(u32x4*)(dst + (size_t)(ntile * 256 + n) * 1024 + kt * 64 + 16 * c) = o; } }
    __syncthreads();
}
__device__ __forceinline__ void wmax_phase(const Params& p, int b0, int nb) {
    int tid = threadIdx.x; asm volatile("" : "+v"(tid));
    for (int it = b0; it < 224; it += nb) {
        const int l = it / 112, r = it % 112, ntile = r >> 2, kg = r & 3, n = tid & 255, k0 = tid >> 8; float am = 0.f;
#pragma unroll 1
        for (int kk = 0; kk < 4; ++kk) { const int kt = kg * 4 + kk; float v[32];
            const float* sp = p.in[3] + (size_t)l * D * IN_TOTAL + (size_t)(kt * 64 + k0) * IN_TOTAL + ntile * 256 + n; const float* gain = p.in[2] + l * D + kt * 64 + k0;
#pragma unroll
            for (int j = 0; j < 32; ++j) v[j] = sp[(size_t)(2 * j) * IN_TOTAL];
            __builtin_amdgcn_sched_barrier(0);
#pragma unroll
            for (int j = 0; j < 32; ++j) am = fmaxf(am, fabsf(v[j] * gain[2 * j])); }
        atomicMax((unsigned*)(p.ws + WS_WMAX) + l * IN_TOTAL + ntile * 256 + n, __float_as_uint(am));
    }
}
constexpr int CT_IN = 16 * 28, CT_MEM = 64, CT_BR = 96, CT_OUT = 64, CT_G = 512, CT_U = 512, CT_D = 512;
constexpr int CT_LAYER = CT_IN + CT_MEM + CT_BR + CT_OUT + CT_G + CT_U + CT_D;
__device__ __forceinline__ void convert_mem_phase(const Params& p, LAS float* tile, int b0, int nb) {
    unsigned char* ws = p.ws;
    for (int m = b0; m < 2 * CT_MEM; m += nb) { const int l = m / CT_MEM, r = m % CT_MEM;
        convert_tile(p.in[9] + (size_t)l * D * D, D, p.in[8] + l * D, (bf16_t*)(ws + WS_WMIX + (size_t)l * WMIX_LAYER + WMIX_MEM), D, 0, 0, r / 4, r % 4, tile); }
}
__device__ __forceinline__ void convert_phase(const Params& p, LAS float* tile, int i0, int istride, int hi) {
    unsigned char* ws = p.ws;
    for (int idx = i0; idx < hi; idx += istride) {
        const int l = idx / CT_LAYER; int r = idx % CT_LAYER;
        bf16_t* wmix = (bf16_t*)(ws + WS_WMIX + (size_t)l * WMIX_LAYER); unsigned char* wmoe = ws + WS_WMOE + (size_t)l * WMOE_LAYER;
        if (r < CT_IN) { convert_tile_i8(p.in[3] + (size_t)l * D * IN_TOTAL, IN_TOTAL, p.in[2] + l * D, (const unsigned*)(ws + WS_WMAX) + l * IN_TOTAL, (float*)(ws + WS_WSC) + l * IN_TOTAL, (unsigned char*)wmix, r / 28, r % 28, tile); continue; } r -= CT_IN;
        if (r < CT_MEM) continue; r -= CT_MEM;
        if (r < CT_BR) { const int i = r / 32, rr = r % 32; convert_tile(p.in[10] + (size_t)(l * 3 + i) * 512 * D, D, nullptr, (bf16_t*)((unsigned char*)wmix + WMIX_BR), 1536, i * 512, 0, rr / 4, rr % 4, tile); continue; } r -= CT_BR;
        if (r < CT_OUT) { convert_tile(p.in[11] + (size_t)l * D * D, D, nullptr, (bf16_t*)((unsigned char*)wmix + WMIX_OUT), D, 0, 0, r / 4, r % 4, tile); continue; } r -= CT_OUT;
        if (r < CT_G) { const int e = r / 32, rr = r % 32; convert_tile8(p.in[15] + (size_t)(l * NE + e) * D * DE, DE, p.in[12] + l * D, wmoe + (size_t)e * 1024 * 1024, D, 1, rr / 2, rr % 2, tile); continue; } r -= CT_G;
        if (r < CT_U) { const int e = r / 32, rr = r % 32; convert_tile8(p.in[16] + (size_t)(l * NE + e) * D * DE, DE, p.in[12] + l * D, wmoe + (size_t)e * 1024 * 1024, D, 2, rr / 2, rr % 2, tile); continue; } r -= CT_U;
        { const int e = r / 32, rr = r % 32; convert_tile8(p.in[17] + (size_t)(l * NE + e) * DE * D, D, nullptr, wmoe + WMOE_D + (size_t)e * 1024 * 512, DE, 0, rr / 4, rr % 4, tile); }
    }
}

__device__ __forceinline__ void prep_row(const float* xrow, bf16_t* orow, float* rs_out, int lane, unsigned char* qrow = nullptr) {
    const f32x4* xr = (const f32x4*)xrow + lane; f32x4 v[4]; float s = 0.f;
#pragma unroll
    for (int j = 0; j < 4; ++j) { v[j] = xr[64 * j]; s += (v[j].x * v[j].x + v[j].y * v[j].y) + (v[j].z * v[j].z + v[j].w * v[j].w); }
    s = wave_sum(s);
    float rsv = 1.0f / sqrtf(s * (1.f / D) + EPS);
    u32x2* o = (u32x2*)orow + lane;
#pragma unroll
    for (int j = 0; j < 4; ++j) { u32x2 w; w.x = pk2(v[j].x, v[j].y); w.y = pk2(v[j].z, v[j].w); o[64 * j] = w; }
    if (qrow) { float am = 0.f;
#pragma unroll
        for (int j = 0; j < 4; ++j) am = fmaxf(am, fmaxf(fmaxf(fabsf(v[j].x), fabsf(v[j].y)), fmaxf(fabsf(v[j].z), fabsf(v[j].w))));
        am = fmaxf(wave_max(am), 1e-30f); const float inv = 127.f / am; rsv *= am * (1.f / 127.f);
        unsigned* q = (unsigned*)qrow + lane;
#pragma unroll
        for (int j = 0; j < 4; ++j) q[64 * j] = pk4_i8(v[j].x * inv, v[j].y * inv, v[j].z * inv, v[j].w * inv); }
    if (lane == 0) *rs_out = rsv;
}
__device__ __forceinline__ void prep_phase(const Params& p, int gw, int ngw, int lane) {
    unsigned char* ws = p.ws;
    for (int r = gw; r < NTOK + NMEM; r += ngw) {
        if (r < NTOK) prep_row(p.in[0] + (size_t)r * D, (bf16_t*)(ws + WS_XB) + (size_t)r * D, (float*)(ws + WS_RS) + r, lane, ws + WS_XB8 + (size_t)r * D);
        else { const int m = r - NTOK; prep_row(p.in[1] + (size_t)m * D, (bf16_t*)(ws + WS_MEMB) + (size_t)m * D, (float*)(ws + WS_RSMEM) + m, lane); }
    }
}

__device__ __forceinline__ void phase_memkv(const Params& p, LAS unsigned char* lds, int l, int c, int G) {
    unsigned char* ws = p.ws;
    pg8::Gemm g{(const bf16_t*)(ws + WS_MEMB), (const bf16_t*)(ws + WS_WMIX + (size_t)l * WMIX_LAYER + WMIX_MEM), D};
    pg8::StaticOrder S; S.init(NMEM, D, G, c);
    pg8::EpiRowBf16<0> E{(bf16_t*)(ws + WS_MKV) + (size_t)l * NMEM * D, D, (const float*)(ws + WS_RSMEM), 1.f};
    pg8::gemm_phase<pg8::EpiRowBf16<0>, pg8::StaticOrder, true>(lds, g, S, E);
}
__device__ __forceinline__ void phase_mix(const Params& p, LAS unsigned char* lds, int l, int half) {
    unsigned char* ws = p.ws;
    pg8::Gemm g{(const bf16_t*)(ws + WS_XB8) + (size_t)half * HT * (D / 2), (const bf16_t*)(ws + WS_WMIX + (size_t)l * WMIX_LAYER), D / 2, (const float*)(ws + WS_WSC) + l * IN_TOTAL};
    pg8::StaticOrder S; S.init(HT, MIXW, gridDim.x, blockIdx.x);
    pg8::EpiMix E{(bf16_t*)(ws + WS_BIG + BG_PB), (_Float16*)(ws + WS_BIG + BG_LOGF), (const float*)(ws + WS_RS) + half * HT, (const float*)(ws + WS_LBS) + l * 512, 0.125f * LOG2E, 0.08838834764831845f * LOG2E, (unsigned*)(ws + WS_KM2) + (size_t)(l * 2 + half) * 4096};
    pg8::gemm_phase<pg8::EpiMix, pg8::StaticOrder, true, 2>(lds, g, S, E);
}
__device__ __forceinline__ void phase_gates(const Params& p, LAS unsigned char* lds, int l, int half) {
    unsigned char* ws = p.ws;
    pg8::Gemm g{(const bf16_t*)(ws + WS_XB8) + (size_t)half * HT * (D / 2), (const bf16_t*)(ws + WS_WMIX + (size_t)l * WMIX_LAYER) + (size_t)MIXW * (D / 2), D / 2, (const float*)(ws + WS_WSC) + l * IN_TOTAL + MIXW};
    pg8::GatesOfMerge S; S.init(HT, D, gridDim.x, blockIdx.x);
    pg8::EpiGatesNative E{ws + WS_BIG + BG_GATES, (const float*)(ws + WS_RS) + half * HT};
    pg8::gemm_phase<pg8::EpiGatesNative, pg8::GatesOfMerge, true, 2>(lds, g, S, E);
}
__device__ __forceinline__ void phase_merge(const Params& p, LAS unsigned char* lds, int l, int half) {
    unsigned char* ws = p.ws;
    pg8::Gemm g{(const bf16_t*)(ws + WS_BIG + BG_YCAT), (const bf16_t*)(ws + WS_WMIX + (size_t)l * WMIX_LAYER + WMIX_BR), 1536};
    pg8::StaticOrder S; S.init(HT, D, gridDim.x, blockIdx.x);
    pg8::EpiMerge E{ws + WS_BIG + BG_GATES, (bf16_t*)(ws + WS_BIG + BG_MERGED) + (size_t)half * HT * D};
    pg8::gemm_phase<pg8::EpiMerge, pg8::StaticOrder, true>(lds, g, S, E);
}
__device__ __forceinline__ void phase_out(const Params& p, LAS unsigned char* lds, int l) {
    unsigned char* ws = p.ws;
    pg8::Gemm g{(const bf16_t*)(ws + WS_BIG + BG_MERGED), (const bf16_t*)(ws + WS_WMIX + (size_t)l * WMIX_LAYER + WMIX_OUT), D};
    pg8::StaticOrder S; S.init(NTOK, D, gridDim.x, blockIdx.x);
    pg8::EpiOut E{(bf16_t*)(ws + WS_XB), ws + WS_XB8};
    pg8::gemm_phase<pg8::EpiOut, pg8::StaticOrder, true>(lds, g, S, E);
}
__device__ __forceinline__ void phase_gateup(const Params& p, LAS unsigned char* lds, int l) {
    unsigned char* ws = p.ws;
    const int ntiles = *(const int*)(ws + WS_NTILES);
    pg8::Gemm g{(const bf16_t*)(ws + WS_XB8), (const bf16_t*)(ws + WS_WMOE + (size_t)l * WMOE_LAYER), D / 2};
    pg8::MoeOrder<true> S; S.init(ntiles * 256, 1024, gridDim.x, blockIdx.x); S.tile_exp = (const int*)(ws + WS_TILEEXP); S.rowtok = (const int*)(ws + WS_ROWTOK); S.estride = (size_t)1024 * 1024; S.cnt = (unsigned*)(ws + WS_MOECNT) + (size_t)l * 272 * 64; S.tmo = (unsigned*)(ws + WS_MOETMO);
    pg8::EpiGateUp E{ws + WS_BIG + BG_ACT, (const float*)(ws + WS_ROWRS), (const float*)(ws + WS_ROWWT)};
    pg8::gemm_phase<pg8::EpiGateUp, pg8::MoeOrder<true>, true, true>(lds, g, S, E);
}
__device__ __forceinline__ void phase_down(const Params& p, LAS unsigned char* lds, int l) {
    unsigned char* ws = p.ws;
    const int ntiles = *(const int*)(ws + WS_NTILES);
    pg8::Gemm g{(const bf16_t*)(ws + WS_BIG + BG_ACT), (const bf16_t*)(ws + WS_WMOE + (size_t)l * WMOE_LAYER + WMOE_D), DE / 2};
    pg8::MoeOrder<false> S; S.init(ntiles * 256, 1024, gridDim.x, blockIdx.x); S.tile_exp = (const int*)(ws + WS_TILEEXP); S.rowtok = nullptr; S.estride = (size_t)1024 * 512; S.cnt = (unsigned*)(ws + WS_MOECNT) + (size_t)l * 272 * 64; S.tmo = (unsigned*)(ws + WS_MOETMO);
    pg8::EpiRowFp8 E{ws + WS_BIG + BG_YSLOT, YS8_SCALE / (W8_SCALE * ACT8_SCALE)};
    pg8::gemm_phase<pg8::EpiRowFp8, pg8::MoeOrder<false>, true, true>(lds, g, S, E);
}

typedef short s16x4 __attribute__((ext_vector_type(4)));
constexpr int KSTR = 272, VSTR = 288;
constexpr int ATT_KBUF = 16384, ATT_STAGE = 32768;
template <bool DIFF>
__device__ __forceinline__ void attn_unit(LAS unsigned char* lds, const bf16_t* Q, int q_ld, const bf16_t* K, int k_ld, const bf16_t* V, int v_ld, int nkt, int i0,
                                          float slope2, float lam, float oscale, const float* sub_g, bf16_t* Y, int y_ld, const unsigned* kmaxp) {
    constexpr int KS = DIFF ? 2 : 4;
    int tid = threadIdx.x; asm volatile("" : "+v"(tid));
    const int wid = __builtin_amdgcn_readfirstlane(tid >> 6), lane = tid & 63, fr = lane & 15, quad = lane >> 4;
    const int map = DIFF ? (wid >> 2) : 0, wq = DIFF ? (wid & 3) : wid, kcol0 = DIFF ? map * 64 : 0;
    const int iw = i0 + 32 * wq;
    const int dr = lane >> 4; const unsigned dlog = (unsigned)((lane & 15) ^ ((dr << 2) | (wid & 3)));
#define ATT_DMA(t, b) do { _Pragma("unroll") for (int _i = 0; _i < 2; ++_i) { const size_t r_ = (size_t)((t) * 64 + 4 * (wid + 8 * _i) + dr); \
        __builtin_amdgcn_global_load_lds((const unsigned*)(K + r_ * k_ld + dlog * 8), (LAS unsigned*)(lds + (b) * ATT_STAGE + (wid + 8 * _i) * 1024), 16, 0, 0); \
        __builtin_amdgcn_global_load_lds((const unsigned*)(V + r_ * v_ld + dlog * 8), (LAS unsigned*)(lds + (b) * ATT_STAGE + ATT_KBUF + (wid + 8 * _i) * 1024), 16, 0, 0); } } while (0)
    ATT_DMA(nkt - 1, 0);
    bf16x8 qf[2][KS];
#pragma unroll
    for (int qb = 0; qb < 2; ++qb)
#pragma unroll
        for (int ks = 0; ks < KS; ++ks) qf[qb][ks] = *(const bf16x8*)(Q + (size_t)(32 * wq + 16 * qb + fr) * q_ld + kcol0 + ks * 32 + quad * 8);
    u32x2 kk2 = {0u, 0u}; if (DIFF && lane < nkt) kk2 = *(const u32x2*)(kmaxp + (map * 64 + lane) * 2);
    f32x4 O[8][2];
#pragma unroll
    for (int db = 0; db < 8; ++db) { O[db][0] = (f32x4){0.f, 0.f, 0.f, 0.f}; O[db][1] = (f32x4){0.f, 0.f, 0.f, 0.f}; }
    float mrow[2] = {0.f, 0.f};
    f32x4 Lacc[2] = {(f32x4){0.f, 0.f, 0.f, 0.f}, (f32x4){0.f, 0.f, 0.f, 0.f}};
    bool noshift = false;
    float qmax = 0.f, kpre = 0.f, mmin = -INFINITY; bool wdone = false; int nact = 0;
    LAS int* dflag = (LAS int*)(lds + 2 * ATT_STAGE);
    if (DIFF) {
        float qs = 0.f;
#pragma unroll
        for (int qb = 0; qb < 2; ++qb) { float a = 0.f;
#pragma unroll
            for (int ks = 0; ks < KS; ++ks)
#pragma unroll
                for (int e = 0; e < 8; ++e) { const float v = bf2f((bf16_t)qf[qb][ks][e]); a += v * v; }
            a += __shfl_xor(a, 16); a += __shfl_xor(a, 32); qs = fmaxf(qs, a); }
#pragma unroll
        for (int o = 1; o < 16; o <<= 1) qs = fmaxf(qs, __shfl_xor(qs, o));
        qmax = __builtin_amdgcn_readfirstlane(sqrtf(qs));
        float v = 0.f; if (lane < nkt) v = sqrtf(__uint_as_float(kk2.x) + __uint_as_float(kk2.y)) * 1.0001f;
#pragma unroll
        for (int o = 1; o < 64; o <<= 1) { const float t_ = __shfl_up(v, o); if (lane >= o) v = fmaxf(v, t_); }
        kpre = v;
        if (tid < 16) dflag[tid] = 0;
    }
    const unsigned fk = (unsigned)(((fr & 3) << 2) | ((fr >> 2) & 3));
    unsigned pk[KS];
#pragma unroll
    for (int ks = 0; ks < KS; ++ks) pk[ks] = (unsigned)(fr * 256) + ((((unsigned)(kcol0 / 8 + 4 * ks + quad)) ^ fk) << 4);
    const int vq = fr >> 2, vp = fr & 3; const unsigned fv = (unsigned)((vq << 2) | quad);
    unsigned pv[8];
#pragma unroll
    for (int db = 0; db < 8; ++db) pv[db] = (unsigned)((4 * quad + vq) * 256) + ((((unsigned)(2 * db + (vp >> 1))) ^ fv) << 4) + 8u * (unsigned)(vp & 1);
    __syncthreads();
    int buf = 0;
    for (int t = nkt - 1; t >= 0; --t) {
        if (t > 0) ATT_DMA(t - 1, buf ^ 1);
        __builtin_amdgcn_sched_barrier(0);
        const int j0 = t * 64;
        if (DIFF && !wdone && nact >= 2) {
            const float dmin = (float)(iw - (j0 + 63));
            if (dmin > 0.f && qmax * __shfl(kpre, t) - slope2 * dmin < mmin - 40.f) wdone = true;
        }
        const bool active = !DIFF || ((j0 <= iw + 31) && !wdone);
        if (DIFF && lane == 0) dflag[(t & 1) * 8 + wid] = wdone ? 1 : 0;
        if (active) {
            const LAS unsigned char* kb_ = lds + buf * ATT_STAGE; const LAS unsigned char* vb_ = kb_ + ATT_KBUF;
            float ib[2];
#pragma unroll
            for (int qb = 0; qb < 2; ++qb) ib[qb] = (DIFF ? slope2 * (float)(j0 + quad * 4 - (iw + 16 * qb + fr)) : 0.f) - mrow[qb];
            f32x4 sacc[4][2];
#pragma unroll
            for (int kb = 0; kb < 4; ++kb) { sacc[kb][0] = (f32x4){ib[0], ib[0], ib[0], ib[0]}; sacc[kb][1] = (f32x4){ib[1], ib[1], ib[1], ib[1]}; }
#pragma unroll
            for (int kb = 0; kb < 4; ++kb)
#pragma unroll
                for (int ks = 0; ks < KS; ++ks) { const bf16x8 kf = *(const LAS bf16x8*)(kb_ + kb * 4096 + pk[ks]);
                    sacc[kb][0] = __builtin_amdgcn_mfma_f32_16x16x32_bf16(kf, qf[0][ks], sacc[kb][0], 0, 0, 0); sacc[kb][1] = __builtin_amdgcn_mfma_f32_16x16x32_bf16(kf, qf[1][ks], sacc[kb][1], 0, 0, 0); }
            bf16x8 pf[2][2];
#pragma unroll
            for (int qb = 0; qb < 2; ++qb) {
                if (DIFF) {
#pragma unroll
                    for (int kb = 0; kb < 4; ++kb)
#pragma unroll
                        for (int jj = 0; jj < 4; ++jj) sacc[kb][qb][jj] = fmaf(slope2, (float)(16 * kb + jj), sacc[kb][qb][jj]);
                    if (j0 + 63 > iw + 16 * qb) { const int iq = iw + 16 * qb + fr;
#pragma unroll
                        for (int kb = 0; kb < 4; ++kb)
#pragma unroll
                            for (int jj = 0; jj < 4; ++jj) if (j0 + 16 * kb + quad * 4 + jj > iq) sacc[kb][qb][jj] = -INFINITY; }
                }
                if (!noshift) {
                    float mx = fmaxf(fmaxf(sacc[0][qb][0], sacc[0][qb][1]), fmaxf(sacc[0][qb][2], sacc[0][qb][3]));
#pragma unroll
                    for (int kb = 1; kb < 4; ++kb) mx = fmaxf(mx, fmaxf(fmaxf(sacc[kb][qb][0], sacc[kb][qb][1]), fmaxf(sacc[kb][qb][2], sacc[kb][qb][3])));
                    if (nact == 0 || __any(mx > 8.f)) {
                        mx = fmaxf(mx, __shfl_xor(mx, 16)); mx = fmaxf(mx, __shfl_xor(mx, 32));
                        const float delta = (nact == 0) ? mx : fmaxf(mx, 0.f); const float alpha = __builtin_amdgcn_exp2f(-delta);
                        mrow[qb] += delta; Lacc[qb] = Lacc[qb] * alpha;
#pragma unroll
                        for (int db = 0; db < 8; ++db) O[db][qb] = O[db][qb] * alpha;
#pragma unroll
                        for (int kb = 0; kb < 4; ++kb) sacc[kb][qb] = sacc[kb][qb] - delta;
                    }
                }
#pragma unroll
                for (int kb = 0; kb < 4; ++kb)
#pragma unroll
                    for (int jj = 0; jj < 4; ++jj) sacc[kb][qb][jj] = __builtin_amdgcn_exp2f(sacc[kb][qb][jj]);
#pragma unroll
                for (int kk = 0; kk < 2; ++kk) { u32x4 w; w.x = cvt_pk_bf16(sacc[2 * kk][qb][0], sacc[2 * kk][qb][1]); w.y = cvt_pk_bf16(sacc[2 * kk][qb][2], sacc[2 * kk][qb][3]);
                    w.z = cvt_pk_bf16(sacc[2 * kk + 1][qb][0], sacc[2 * kk + 1][qb][1]); w.w = cvt_pk_bf16(sacc[2 * kk + 1][qb][2], sacc[2 * kk + 1][qb][3]); pf[qb][kk] = __builtin_bit_cast(bf16x8, w); }
            }
            { const u32x4 o1 = (u32x4){0x3f803f80u, 0x3f803f80u, 0x3f803f80u, 0x3f803f80u}; const bf16x8 ones = __builtin_bit_cast(bf16x8, o1);
#pragma unroll
              for (int kk = 0; kk < 2; ++kk) { Lacc[0] = __builtin_amdgcn_mfma_f32_16x16x32_bf16(ones, pf[0][kk], Lacc[0], 0, 0, 0); Lacc[1] = __builtin_amdgcn_mfma_f32_16x16x32_bf16(ones, pf[1][kk], Lacc[1], 0, 0, 0); } }
#pragma unroll
            for (int db = 0; db < 8; ++db)
#pragma unroll
                for (int kk = 0; kk < 2; ++kk) {
                    const LAS unsigned char* va_ = vb_ + kk * 8192 + pv[db];
                    const s16x4 v0 = __builtin_amdgcn_ds_read_tr16_b64_v4i16((LAS s16x4*)va_), v1 = __builtin_amdgcn_ds_read_tr16_b64_v4i16((LAS s16x4*)(va_ + 4096));
                    bf16x8 vf; vf[0] = v0[0]; vf[1] = v0[1]; vf[2] = v0[2]; vf[3] = v0[3]; vf[4] = v1[0]; vf[5] = v1[1]; vf[6] = v1[2]; vf[7] = v1[3];
                    O[db][0] = __builtin_amdgcn_mfma_f32_16x16x32_bf16(vf, pf[0][kk], O[db][0], 0, 0, 0); O[db][1] = __builtin_amdgcn_mfma_f32_16x16x32_bf16(vf, pf[1][kk], O[db][1], 0, 0, 0);
                }
            if (DIFF && nact == 0) noshift = (qmax * __shfl(kpre, nkt - 1) < 50.f);
            if (DIFF && nact < 2) { float mm = fminf(mrow[0], mrow[1]);
#pragma unroll
                for (int o = 1; o < 16; o <<= 1) mm = fminf(mm, __shfl_xor(mm, o));
                mmin = __builtin_amdgcn_readfirstlane(mm); }
            ++nact;
        }
        __syncthreads();
        buf ^= 1;
        if (DIFF) { const LAS int* f_ = dflag + (t & 1) * 8; const u32x4 fa = *(const LAS u32x4*)f_, fb = *(const LAS u32x4*)(f_ + 4);
            if ((fa.x & fa.y & fa.z & fa.w & fb.x & fb.y & fb.z & fb.w) != 0u) break; }
    }
    if (DIFF) __syncthreads();
#undef ATT_DMA
    float inv[2];
#pragma unroll
    for (int qb = 0; qb < 2; ++qb) inv[qb] = 1.0f / Lacc[qb][0];
    if (DIFF) {
        LAS float* xch = (LAS float*)lds;
        if (map == 1) {
#pragma unroll
            for (int db = 0; db < 8; ++db)
#pragma unroll
                for (int qb = 0; qb < 2; ++qb)
#pragma unroll
                    for (int jj = 0; jj < 4; ++jj) xch[(wq * 64 + (db * 2 + qb) * 4 + jj) * 64 + lane] = O[db][qb][jj] * inv[qb] * lam;
        }
        __syncthreads();
        if (map == 0) {
            f32x4 gv[8];
#pragma unroll
            for (int db = 0; db < 8; ++db) gv[db] = *(const f32x4*)(sub_g + 16 * db + quad * 4);
#pragma unroll
            for (int qb = 0; qb < 2; ++qb) {
                float ss = 0.f;
#pragma unroll
                for (int db = 0; db < 8; ++db)
#pragma unroll
                    for (int jj = 0; jj < 4; ++jj) { const float o = O[db][qb][jj] * inv[qb] - xch[(wq * 64 + (db * 2 + qb) * 4 + jj) * 64 + lane]; O[db][qb][jj] = o; ss += o * o; }
                ss += __shfl_xor(ss, 16); ss += __shfl_xor(ss, 32);
                const float r = oscale / sqrtf(ss * (1.f / 128.f) + EPS);
                bf16_t* yr = Y + (size_t)(32 * wq + 16 * qb + fr) * y_ld + quad * 4;
#pragma unroll
                for (int db = 0; db < 8; ++db) { const f32x4 g = gv[db]; u32x2 w; w.x = cvt_pk_bf16(O[db][qb][0] * r * g[0], O[db][qb][1] * r * g[1]); w.y = cvt_pk_bf16(O[db][qb][2] * r * g[2], O[db][qb][3] * r * g[3]);
                    *(u32x2*)(yr + 16 * db) = w; }
            }
        }
        __syncthreads();
    } else {
#pragma unroll
        for (int qb = 0; qb < 2; ++qb) { bf16_t* yr = Y + (size_t)(32 * wq + 16 * qb + fr) * y_ld + quad * 4;
#pragma unroll
            for (int db = 0; db < 8; ++db) { u32x2 w; w.x = cvt_pk_bf16(O[db][qb][0] * inv[qb], O[db][qb][1] * inv[qb]); w.y = cvt_pk_bf16(O[db][qb][2] * inv[qb], O[db][qb][3] * inv[qb]); *(u32x2*)(yr + 16 * db) = w; } }
    }
}
constexpr size_t WS_QCTR = 8192;

constexpr size_t WS_BTOT = 3 * MiB + 786432;
constexpr int HL_QH = 0, HL_KH = 17408, HL_Q1 = 34816, HL_K2 = 52224, HL_VT = 70656, HL_AT = 89088, HL_SEG = 98304, HL_D = 102400, HL_ER = 136704, HL_ETR = 137216;
constexpr int ATSTR = 144;
struct HgIn { unsigned lfh[8]; unsigned q[8]; u32x4 v[2]; };
template <bool FULL>
__device__ __forceinline__ void hg_load(HgIn& in, const _Float16* lf, const bf16_t* hq, const bf16_t* hv) {
    int tid = threadIdx.x; asm volatile("" : "+v"(tid)); const int kp = tid & 63, tq = tid >> 6;
#pragma unroll
    for (int i = 0; i < 8; ++i) { in.lfh[i] = *(const unsigned*)(lf + (size_t)(8 * tq + i) * 512 + 2 * kp); if (FULL) in.q[i] = *(const unsigned*)(hq + (size_t)(8 * tq + i) * 512 + 2 * kp); }
    const int srow = tid >> 4, sc = tid & 15;
#pragma unroll
    for (int i = 0; i < 2; ++i) in.v[i] = *(const u32x4*)(hv + (size_t)(srow + 32 * i) * 512 + sc * 8);
    __builtin_amdgcn_sched_barrier(0);
}
template <bool FULL>
__device__ __forceinline__ f32x2 hg_build(LAS unsigned char* lds, const HgIn& in, f32x2 Radd) {
    int tid = threadIdx.x; asm volatile("" : "+v"(tid)); const int kp = tid & 63, tq = tid >> 6;
    f32x2 cum[8]; f32x2 c = (f32x2){0.f, 0.f};
    typedef _Float16 h16x2 __attribute__((ext_vector_type(2))); f32x2 lfv[8];
#pragma unroll
    for (int i = 0; i < 8; ++i) { const h16x2 h_ = __builtin_bit_cast(h16x2, in.lfh[i]); lfv[i] = (f32x2){(float)h_[0], (float)h_[1]}; c = c + lfv[i]; cum[i] = c; }
    LAS float* seg = (LAS float*)(lds + HL_SEG);
    *(LAS f32x2*)(seg + tq * 128 + 2 * kp) = c;
    { const int srow = tid >> 4, sc = tid & 15;
#pragma unroll
      for (int i = 0; i < 2; ++i) *(LAS u32x4*)(lds + HL_VT + (srow + 32 * i) * VSTR + sc * 16) = in.v[i]; }
    lds_barrier();
    f32x2 pre = (f32x2){0.f, 0.f}, tot = (f32x2){0.f, 0.f}, r = (f32x2){0.f, 0.f};
#pragma unroll
    for (int q = 0; q < 8; ++q) { const f32x2 v = *(const LAS f32x2*)(seg + q * 128 + 2 * kp); tot = tot + v; if (q < 4) r = r + v; if (q < tq) pre = pre + v; }
    const f32x2 er = (f32x2){__expf(r.x), __expf(r.y)}, etr = (f32x2){__expf(tot.x - r.x + Radd.x), __expf(tot.y - r.y + Radd.y)};
#pragma unroll
    for (int i = 0; i < 8; ++i) {
        const int t = 8 * tq + i; const f32x2 b = pre + cum[i];
        const float kk0 = 1.f - __expf(lfv[i].x), kk1 = 1.f - __expf(lfv[i].y);
        const float e10 = __expf(fminf(fmaxf(b.x - r.x, -80.f), 80.f)), e11 = __expf(fminf(fmaxf(b.y - r.y, -80.f), 80.f));
        const float i10 = __builtin_amdgcn_rcpf(e10), i11 = __builtin_amdgcn_rcpf(e11);
        const float kh0 = kk0 * i10, kh1 = kk1 * i11;
        if (FULL) {
            const float q0 = __uint_as_float(in.q[i] << 16), q1 = __uint_as_float(in.q[i] & 0xffff0000u);
            *(LAS unsigned*)(lds + HL_QH + t * KSTR + kp * 4) = cvt_pk_bf16(q0 * e10, q1 * e11);
            *(LAS unsigned*)(lds + HL_KH + t * KSTR + kp * 4) = cvt_pk_bf16(kh0, kh1);
        } else {
            *(LAS unsigned*)(lds + HL_K2 + t * VSTR + kp * 4) = cvt_pk_bf16(kh0 * etr.x, kh1 * etr.y);
        }
    }
    if (FULL && tq == 1) { *(LAS f32x2*)(lds + HL_ER + kp * 8) = er; *(LAS f32x2*)(lds + HL_ETR + kp * 8) = etr; }
    if (FULL && tq == 0) *(LAS f32x2*)(lds + HL_D + kp * 8) = (f32x2){__expf(tot.x), __expf(tot.y)};
    return tot;
}
__device__ __forceinline__ bf16x8 tr_frag(const LAS unsigned char* base, int stride, int kk, int cb, int lane) {
    const int fr = lane & 15, quad = lane >> 4; const LAS unsigned char* a = base + (32 * kk + 8 * quad + (fr >> 2)) * stride + 32 * cb + 8 * (fr & 3);
    const s16x4 v0 = __builtin_amdgcn_ds_read_tr16_b64_v4i16((LAS s16x4*)a), v1 = __builtin_amdgcn_ds_read_tr16_b64_v4i16((LAS s16x4*)(a + 4 * stride));
    bf16x8 f; f[0] = v0[0]; f[1] = v0[1]; f[2] = v0[2]; f[3] = v0[3]; f[4] = v1[0]; f[5] = v1[1]; f[6] = v1[2]; f[7] = v1[3]; return f;
}
__device__ __forceinline__ void phase_hgrnA(const Params& p, LAS unsigned char* lds, int b0, int nb) {
    unsigned char* ws = p.ws; int tid = threadIdx.x; asm volatile("" : "+v"(tid)); const int wid = __builtin_amdgcn_readfirstlane(tid >> 6), lane = tid & 63;
    const bf16_t* hv = (const bf16_t*)(ws + WS_BIG + BG_PB) + (size_t)SL_HV * HT * 512; const _Float16* lf = (const _Float16*)(ws + WS_BIG + BG_LOGF);
    for (int u = b0; u < 256; u += nb) {
        const int j = u & 15, h = (u >> 4) & 3, bl = u >> 6; const size_t tok0 = (size_t)bl * SEQ + j * 256;
        f32x4 acc[8];
#pragma unroll
        for (int kb = 0; kb < 8; ++kb) acc[kb] = (f32x4){0.f, 0.f, 0.f, 0.f};
        f32x2 R = (f32x2){0.f, 0.f};
        HgIn cur; { const size_t tb = (tok0 + 64 * 3) * 512 + h * 128; hg_load<false>(cur, lf + tb, nullptr, hv + tb); }
#pragma unroll 1
        for (int c = 3; c >= 0; --c) {
            R = R + hg_build<false>(lds, cur, R);
            lds_barrier();
            if (c > 0) { const size_t tb = (tok0 + 64 * (c - 1)) * 512 + h * 128; hg_load<false>(cur, lf + tb, nullptr, hv + tb); }
            bf16x8 vf[2]; vf[0] = tr_frag(lds + HL_VT, VSTR, 0, wid, lane); vf[1] = tr_frag(lds + HL_VT, VSTR, 1, wid, lane);
#pragma unroll
            for (int kb = 0; kb < 8; ++kb)
#pragma unroll
                for (int kk = 0; kk < 2; ++kk) acc[kb] = __builtin_amdgcn_mfma_f32_16x16x32_bf16(tr_frag(lds + HL_K2, VSTR, kk, kb, lane), vf[kk], acc[kb], 0, 0, 0);
            lds_barrier();
        }
        float* Ln = (float*)(ws + WS_ST) + (size_t)u * 16384 + wid * 2048;
#pragma unroll
        for (int kb = 0; kb < 8; ++kb) *(f32x4*)(Ln + (kb * 64 + lane) * 4) = acc[kb];
        if (tid < 64) *(f32x2*)((float*)(ws + WS_BTOT) + u * 128 + 2 * tid) = (f32x2){__expf(R.x), __expf(R.y)};
    }
}
constexpr int HL_DTAB = 138240;
constexpr int HL_OB = 102912, OBSTR = 132;
__device__ __forceinline__ void hgrnC_unit(const Params& p, LAS unsigned char* lds, int l, int u) {
    unsigned char* ws = p.ws; int tid = threadIdx.x; asm volatile("" : "+v"(tid)); const int wid = __builtin_amdgcn_readfirstlane(tid >> 6), lane = tid & 63, fr = lane & 15, quad = lane >> 4;
    const bf16_t* hq = (const bf16_t*)(ws + WS_BIG + BG_PB) + (size_t)SL_HQ * HT * 512; const bf16_t* hv = (const bf16_t*)(ws + WS_BIG + BG_PB) + (size_t)SL_HV * HT * 512;
    const bf16_t* hgp = (const bf16_t*)(ws + WS_BIG + BG_PB) + (size_t)SL_HG * HT * 512; bf16_t* ycat = (bf16_t*)(ws + WS_BIG + BG_YCAT);
    const _Float16* lf = (const _Float16*)(ws + WS_BIG + BG_LOGF);
    const int j = u & 15, h = (u >> 4) & 3, bl = u >> 6; const size_t tok0 = (size_t)bl * SEQ + j * 256;
    HgIn cur; { const size_t tb = tok0 * 512 + h * 128; hg_load<true>(cur, lf + tb, hq + tb, hv + tb); }
    f32x4 acc[8];
#pragma unroll
    for (int kb = 0; kb < 8; ++kb) acc[kb] = (f32x4){0.f, 0.f, 0.f, 0.f};
    if (j > 0) {
        const float* Lb = (const float*)(ws + WS_ST) + (size_t)(u - j) * 16384 + wid * 2048 + lane * 4; const int jm = j - 1;
        f32x4 l0[8], l1[8], l2[8];
#define HG_LD(dst, jp_) do { const float* Ln_ = Lb + (size_t)((jp_) < jm ? (jp_) : jm) * 16384; _Pragma("unroll") for (int kb = 0; kb < 8; ++kb) dst[kb] = *(const f32x4*)(Ln_ + kb * 256); } while (0)
#define HG_FOLD(src, jp_) do { _Pragma("unroll") for (int kb = 0; kb < 8; ++kb) acc[kb] = acc[kb] * *(const LAS f32x4*)(lds + HL_DTAB + ((jp_) * 128 + 16 * kb + quad * 4) * 4) + src[kb]; } while (0)
        HG_LD(l0, 0); HG_LD(l1, 1); HG_LD(l2, 2);
        { const float* Dt = (const float*)(ws + WS_BTOT) + (u - j) * 128; for (int i = tid; i < j * 128; i += NTHREADS) ((LAS float*)(lds + HL_DTAB))[i] = Dt[i]; }
        __syncthreads();
#pragma unroll 1
        for (int jp = 0; jp < j; jp += 3) {
            HG_FOLD(l0, jp); HG_LD(l0, jp + 3);
            if (jp + 1 < j) { HG_FOLD(l1, jp + 1); HG_LD(l1, jp + 4); }
            if (jp + 2 < j) { HG_FOLD(l2, jp + 2); HG_LD(l2, jp + 5); }
        }
#undef HG_LD
#undef HG_FOLD
    }
    const float g0 = p.in[7][l * 128 + lane], g1 = p.in[7][l * 128 + 64 + lane];
#pragma unroll 1
    for (int c = 0; c < 4; ++c) {
        (void)hg_build<true>(lds, cur, (f32x2){0.f, 0.f});
        lds_barrier();
        { const int tbk = wid >> 1;
#pragma unroll
          for (int e = 0; e < 2; ++e) { const int sbk = 2 * (wid & 1) + e; f32x4 sa = (f32x4){0.f, 0.f, 0.f, 0.f};
              if (sbk <= tbk) {
#pragma unroll
                  for (int ks = 0; ks < 4; ++ks) { const bf16x8 a = *(const LAS bf16x8*)(lds + HL_QH + (16 * tbk + fr) * KSTR + (ks * 32 + quad * 8) * 2), b = *(const LAS bf16x8*)(lds + HL_KH + (16 * sbk + fr) * KSTR + (ks * 32 + quad * 8) * 2);
                      sa = __builtin_amdgcn_mfma_f32_16x16x32_bf16(a, b, sa, 0, 0, 0); } }
#pragma unroll
              for (int jj = 0; jj < 4; ++jj) { const int t = 16 * tbk + quad * 4 + jj, sidx = 16 * sbk + fr; const float v = (sidx <= t) ? sa[jj] : 0.f; *(LAS bf16_t*)(lds + HL_AT + t * ATSTR + sidx * 2) = (bf16_t)f2bf(v); } } }
        bf16_t ha[8], hb[8];
#pragma unroll
        for (int i = 0; i < 8; ++i) { const bf16_t* hg = hgp + (tok0 + 64 * c + wid * 8 + i) * 512 + h * 128; ha[i] = hg[lane]; hb[i] = hg[64 + lane]; }
        __builtin_amdgcn_sched_barrier(0);
        if (c < 3) { const size_t tb = (tok0 + 64 * (c + 1)) * 512 + h * 128; hg_load<true>(cur, lf + tb, hq + tb, hv + tb); }
        lds_barrier();
        bf16x8 vf[2]; vf[0] = tr_frag(lds + HL_VT, VSTR, 0, wid, lane); vf[1] = tr_frag(lds + HL_VT, VSTR, 1, wid, lane);
        bf16x8 sf[4];
#pragma unroll
        for (int kk = 0; kk < 4; ++kk) { const f32x4 e0 = *(const LAS f32x4*)(lds + HL_ER + (32 * kk + quad * 4) * 4), e1 = *(const LAS f32x4*)(lds + HL_ER + (32 * kk + 16 + quad * 4) * 4); const f32x4 a0 = acc[2 * kk] * e0, a1 = acc[2 * kk + 1] * e1;
            u32x4 w; w.x = cvt_pk_bf16(a0[0], a0[1]); w.y = cvt_pk_bf16(a0[2], a0[3]); w.z = cvt_pk_bf16(a1[0], a1[1]); w.w = cvt_pk_bf16(a1[2], a1[3]); sf[kk] = __builtin_bit_cast(bf16x8, w); }
#pragma unroll
        for (int tbk = 0; tbk < 4; ++tbk) {
            f32x4 o = (f32x4){0.f, 0.f, 0.f, 0.f};
#pragma unroll
            for (int ks = 0; ks < 2; ++ks) { const bf16x8 a = *(const LAS bf16x8*)(lds + HL_AT + (16 * tbk + fr) * ATSTR + (ks * 32 + quad * 8) * 2); o = __builtin_amdgcn_mfma_f32_16x16x32_bf16(a, vf[ks], o, 0, 0, 0); }
#pragma unroll
            for (int kk = 0; kk < 4; ++kk) { const LAS unsigned char* qp = lds + HL_QH + (16 * tbk + fr) * KSTR + (32 * kk + quad * 4) * 2; const u32x2 a0 = *(const LAS u32x2*)qp, a1 = *(const LAS u32x2*)(qp + 32);
                u32x4 aw; aw.x = a0.x; aw.y = a0.y; aw.z = a1.x; aw.w = a1.y; o = __builtin_amdgcn_mfma_f32_16x16x32_bf16(__builtin_bit_cast(bf16x8, aw), sf[kk], o, 0, 0, 0); }
#pragma unroll
            for (int jj = 0; jj < 4; ++jj) ((LAS float*)(lds + HL_OB))[(16 * tbk + quad * 4 + jj) * OBSTR + 16 * wid + fr] = o[jj];
        }
#pragma unroll
        for (int kb = 0; kb < 8; ++kb) { const f32x4 dv = *(const LAS f32x4*)(lds + HL_D + (16 * kb + quad * 4) * 4), ev = *(const LAS f32x4*)(lds + HL_ETR + (16 * kb + quad * 4) * 4);
            f32x4 tmp = (f32x4){0.f, 0.f, 0.f, 0.f};
#pragma unroll
            for (int kk = 0; kk < 2; ++kk) tmp = __builtin_amdgcn_mfma_f32_16x16x32_bf16(tr_frag(lds + HL_KH, KSTR, kk, kb, lane), vf[kk], tmp, 0, 0, 0);
            acc[kb] = acc[kb] * dv + tmp * ev; }
        lds_barrier();
        { float o0[8], o1[8], ss[8];
#pragma unroll
          for (int i = 0; i < 8; ++i) { const LAS float* orow = (const LAS float*)(lds + HL_OB) + (wid * 8 + i) * OBSTR; o0[i] = orow[lane]; o1[i] = orow[64 + lane]; ss[i] = o0[i] * o0[i] + o1[i] * o1[i]; }
#pragma unroll
          for (int o = 1; o < 64; o <<= 1)
#pragma unroll
              for (int i = 0; i < 8; ++i) ss[i] += __shfl_xor(ss[i], o);
#pragma unroll
          for (int i = 0; i < 8; ++i) { const float rr = 1.0f / sqrtf(ss[i] * (1.f / 128.f) + EPS); bf16_t* y = ycat + (tok0 + 64 * c + wid * 8 + i) * 1536 + 512 + h * 128;
              y[lane] = (bf16_t)f2bf(o0[i] * rr * g0 * bf2f(ha[i])); y[64 + lane] = (bf16_t)f2bf(o1[i] * rr * g1 * bf2f(hb[i])); } }
    }
    __syncthreads();
}
__device__ __forceinline__ void phase_diff(const Params& p, LAS unsigned char* lds, int l, int half) {
    unsigned char* ws = p.ws;
    const bf16_t* qa = (const bf16_t*)(ws + WS_BIG + BG_PB) + (size_t)SL_QA * HT * 512; const bf16_t* ka = (const bf16_t*)(ws + WS_BIG + BG_PB) + (size_t)SL_KA * HT * 512;
    const bf16_t* va = (const bf16_t*)(ws + WS_BIG + BG_PB) + (size_t)SL_VA * HT * 512; bf16_t* ycat = (bf16_t*)(ws + WS_BIG + BG_YCAT);
    const float lam = ((const float*)(ws + WS_LAM))[l]; const float lam_init = 0.8f - 0.6f * __expf(-0.3f * (float)l);
    unsigned* qctr = (unsigned*)(ws + WS_QCTR) + 64 * (l * 2 + half); LAS unsigned* uslot = (LAS unsigned*)(lds + LDS_BYTES - 32);
#pragma unroll 1
    for (;;) {
        if (threadIdx.x == 0) *uslot = __hip_atomic_fetch_add(qctr, 1u, __ATOMIC_RELAXED, __HIP_MEMORY_SCOPE_AGENT);
        __syncthreads();
        int idx = (int)*uslot;
        if (idx >= 1024) break;
        if (idx >= 768) {
            const int u = idx - 768, qt = u & 15, hh = (u >> 4) & 3, bl = u >> 6; const int b = half * HB + bl;
            const bf16_t* cq = (const bf16_t*)(ws + WS_BIG + BG_PB) + (size_t)SL_CQ * HT * 512;
            const bf16_t* mkv = (const bf16_t*)(ws + WS_MKV) + (size_t)l * NMEM * D + (size_t)b * MEMLEN * D + hh * 128; const size_t t0 = (size_t)bl * SEQ + qt * 256;
            attn_unit<false>(lds, cq + t0 * 512 + hh * 128, 512, mkv, D, mkv + 512, D, MEMLEN / 64, 0, 0.f, 0.f, 0.f, nullptr, ycat + t0 * 1536 + 1024 + hh * 128, 1536, nullptr);
            continue;
        }
        if (idx >= 256 && idx < 512) { hgrnC_unit(p, lds, l, idx - 256); continue; }
        if (idx >= 512) idx -= 256;
        const int h = 3 - (idx >> 7), rem = idx & 127, qt = 31 - (rem >> 2), bl = rem & 3; const float slope2 = exp2f(-2.0f * (float)(h + 1)) * LOG2E;
        const size_t tb = (size_t)bl * SEQ; const int i0 = qt * 128;
        attn_unit<true>(lds, qa + (tb + i0) * 512 + h * 128, 512, ka + tb * 512 + h * 128, 512, va + tb * 512 + h * 128, 512, 2 * (qt + 1), i0, slope2, lam, 1.f - lam_init, p.in[5] + l * 128,
                        ycat + (tb + i0) * 1536 + h * 128, 1536, (const unsigned*)(ws + WS_KM2) + (size_t)(l * 2 + half) * 4096 + (bl * 4 + h) * 256);
    }
}

__device__ __forceinline__ void route_phase(const Params& p, int l, LAS unsigned char* lds, int b0, int nb) {
    unsigned char* ws = p.ws; int tid = threadIdx.x; asm volatile("" : "+v"(tid)); const int lane = tid & 63, wv = tid >> 6, fr = lane & 15, quad = lane >> 4;
    const float* bias = p.in[14];
    LAS float* wtab = (LAS float*)lds; LAS int* hist = (LAS int*)(lds + 65536);
    { const f32x4* src = (const f32x4*)((const float*)(ws + WS_WRT) + l * 16384);
      f32x4 tv[8];
#pragma unroll
      for (int i = 0; i < 8; ++i) tv[i] = src[tid + 512 * i];
      __builtin_amdgcn_sched_barrier(0);
#pragma unroll
      for (int i = 0; i < 8; ++i) ((LAS f32x4*)wtab)[tid + 512 * i] = tv[i]; }
    const f32x4 bv = *(const f32x4*)(bias + quad * 4);
    __syncthreads();
    for (int ch = b0; ch < NTOK / 128; ch += nb) {
        if (tid < 16) hist[tid] = 0;
        __syncthreads();
        const int tok = ch * 128 + wv * 16 + fr; const u32x2* xr = (const u32x2*)((const bf16_t*)(ws + WS_XB) + (size_t)tok * D) + quad;
        f32x4 acc = (f32x4){0.f, 0.f, 0.f, 0.f}; float ss = 0.f;
        u32x2 xall[64];
#pragma unroll
        for (int sidx = 0; sidx < 64; ++sidx) xall[sidx] = xr[4 * sidx];
        __builtin_amdgcn_sched_barrier(0);
#pragma unroll
        for (int sidx = 0; sidx < 64; ++sidx) {
            const u32x2 xb2 = xall[sidx]; const f32x4 xv = (f32x4){__uint_as_float(xb2.x << 16), __uint_as_float(xb2.x & 0xffff0000u), __uint_as_float(xb2.y << 16), __uint_as_float(xb2.y & 0xffff0000u)}; const f32x4 wv4 = *(const LAS f32x4*)(wtab + ((sidx * 4 + quad) * 16 + fr) * 4);
            ss += (xv.x * xv.x + xv.y * xv.y) + (xv.z * xv.z + xv.w * xv.w);
            acc = __builtin_amdgcn_mfma_f32_16x16x4f32(wv4.x, xv.x, acc, 0, 0, 0); acc = __builtin_amdgcn_mfma_f32_16x16x4f32(wv4.y, xv.y, acc, 0, 0, 0);
            acc = __builtin_amdgcn_mfma_f32_16x16x4f32(wv4.z, xv.z, acc, 0, 0, 0); acc = __builtin_amdgcn_mfma_f32_16x16x4f32(wv4.w, xv.w, acc, 0, 0, 0);
        }
        ss += __shfl_xor(ss, 16); ss += __shfl_xor(ss, 32);
        const float r = 1.0f / sqrtf(ss * (1.f / D) + EPS);
        float a = -INFINITY, b = -INFINITY, sa = 0.f, sb = 0.f; int ia = 0, ib = 0;
#pragma unroll
        for (int k = 0; k < 4; ++k) { const float scv = 1.f / (1.f + expf(-acc[k] * r)); const float v = scv + bv[k]; const int e = quad * 4 + k;
            if (v > a) { b = a; ib = ia; sb = sa; a = v; ia = e; sa = scv; } else if (v > b) { b = v; ib = e; sb = scv; } }
        const float gs = a + b;
        int best = 0; float bestv = __shfl(gs, fr);
#pragma unroll
        for (int g = 1; g < 4; ++g) { const float v = __shfl(gs, fr + 16 * g); if (v > bestv) { bestv = v; best = g; } }
        if (quad == best) { const float inv = 1.f / (sa + sb); u32x4 ti4; ti4.x = (unsigned)ia; ti4.y = (unsigned)ib; ti4.z = __float_as_uint(sa * inv); ti4.w = __float_as_uint(sb * inv);
            *(u32x4*)(ws + WS_TOKINFO + (size_t)tok * 16) = ti4; ((float*)(ws + WS_RS))[tok] = r; atomicAdd((int*)&hist[ia], 1); atomicAdd((int*)&hist[ib], 1); }
        __syncthreads();
        if (tid < 16) ((int*)(ws + WS_CHUNKCNT))[ch * 16 + tid] = hist[tid];
        __syncthreads();
    }
}

__device__ __forceinline__ void lists_phase(const Params& p, LAS int* sm, int b0, int nb) {
    unsigned char* ws = p.ws; int tid = threadIdx.x; asm volatile("" : "+v"(tid));
    const int* cc = (const int*)(ws + WS_CHUNKCNT); int* rowtok = (int*)(ws + WS_ROWTOK); float* rowwt = (float*)(ws + WS_ROWWT); float* rowrs = (float*)(ws + WS_ROWRS);
    int* pos = (int*)(ws + WS_POS); const float* rs = (const float*)(ws + WS_RS);
    LAS int* part = sm;
    LAS int* tot = sm + 512;
    LAS int* start = sm + 528;
    LAS int* base = sm + 560;
    LAS int* e0s = sm + 576;
    LAS int* e1s = sm + 704;
    for (int ch = b0; ch < NTOK / 128; ch += nb) {
        { const int e = tid & 15, pt = tid >> 4; int s = 0; for (int c = pt * 8; c < pt * 8 + 8; ++c) s += cc[c * 16 + e]; part[pt * 16 + e] = s; }
        __syncthreads();
        if (tid < 16) { int s = 0; for (int pt = 0; pt < 32; ++pt) s += part[pt * 16 + tid]; tot[tid] = s; }
        __syncthreads();
        if (tid == 0) { int s = 0; for (int e = 0; e < 16; ++e) { start[e] = s; s += ((tot[e] + 255) >> 8) << 8; } start[16] = s; }
        __syncthreads();
        if (tid < 16) { int s = start[tid]; const int pf = ch >> 3; for (int pt = 0; pt < pf; ++pt) s += part[pt * 16 + tid]; for (int c = pf * 8; c < ch; ++c) s += cc[c * 16 + tid]; base[tid] = s; }
        if (tid < 128) { const u32x4 ti = *(const u32x4*)(ws + WS_TOKINFO + (size_t)(ch * 128 + tid) * 16); e0s[tid] = (int)ti.x; e1s[tid] = (int)ti.y; }
        __syncthreads();
        if (tid < 128) {
            const int tok = ch * 128 + tid; const u32x4 ti = *(const u32x4*)(ws + WS_TOKINFO + (size_t)tok * 16);
            const int e0 = (int)ti.x, e1 = (int)ti.y; int r0 = 0, r1 = 0;
            for (int j = 0; j < tid; ++j) { const int a = e0s[j], b = e1s[j]; r0 += (a == e0 || b == e0) ? 1 : 0; r1 += (a == e1 || b == e1) ? 1 : 0; }
            const int p0 = base[e0] + r0, p1 = base[e1] + r1; const float r = rs[tok];
            rowtok[p0] = tok; rowwt[p0] = __uint_as_float(ti.z); rowrs[p0] = r; rowtok[p1] = tok; rowwt[p1] = __uint_as_float(ti.w); rowrs[p1] = r;
            pos[tok * 2] = p0; pos[tok * 2 + 1] = p1;
        }
        if (ch < 16) {
            const int e = ch, s0 = start[e] + tot[e], s1 = start[e + 1];
            for (int r = s0 + tid; r < s1; r += NTHREADS) { rowtok[r] = 0; rowwt[r] = 0.f; rowrs[r] = 0.f; }
            for (int t = (start[e] >> 8) + tid; t < (s1 >> 8); t += NTHREADS) ((int*)(ws + WS_TILEEXP))[t] = e;
            if (e == 0 && tid == 0) *(int*)(ws + WS_NTILES) = start[16] >> 8;
        }
        __syncthreads();
    }
}

struct CombRows { u32x2 xa[4]; unsigned ya[4], yb[4]; };
__device__ __forceinline__ void comb_load(CombRows& r, const unsigned char* ws, int tok, int p0, int p1, int lane) {
    const u32x2* xr = (const u32x2*)((const bf16_t*)(ws + WS_XB) + (size_t)tok * D) + lane; const unsigned char* ys = ws + WS_BIG + BG_YSLOT;
    const unsigned* y0 = (const unsigned*)(ys + (size_t)p0 * D) + lane; const unsigned* y1 = (const unsigned*)(ys + (size_t)p1 * D) + lane;
#pragma unroll
    for (int j = 0; j < 4; ++j) { r.xa[j] = xr[64 * j]; r.ya[j] = y0[64 * j]; r.yb[j] = y1[64 * j]; }
}
__device__ __forceinline__ void comb_finish(const Params& p, const CombRows& c, const f32x4 (&gfv)[4], int l, int tok, int lane) {
    unsigned char* ws = p.ws;
    f32x4 v[4]; float s = 0.f;
#pragma unroll
    for (int j = 0; j < 4; ++j) {
        const f32x2 a01 = __builtin_amdgcn_cvt_pk_f32_fp8((int)c.ya[j], false), a23 = __builtin_amdgcn_cvt_pk_f32_fp8((int)c.ya[j], true), b01 = __builtin_amdgcn_cvt_pk_f32_fp8((int)c.yb[j], false), b23 = __builtin_amdgcn_cvt_pk_f32_fp8((int)c.yb[j], true);
        constexpr float ysc = 1.f / YS8_SCALE;
        v[j].x = __uint_as_float(c.xa[j].x << 16) + (a01[0] + b01[0]) * ysc; v[j].y = __uint_as_float(c.xa[j].x & 0xffff0000u) + (a01[1] + b01[1]) * ysc;
        v[j].z = __uint_as_float(c.xa[j].y << 16) + (a23[0] + b23[0]) * ysc; v[j].w = __uint_as_float(c.xa[j].y & 0xffff0000u) + (a23[1] + b23[1]) * ysc;
        s += (v[j].x * v[j].x + v[j].y * v[j].y) + (v[j].z * v[j].z + v[j].w * v[j].w); }
    s = wave_sum(s); const float r = 1.0f / sqrtf(s * (1.f / D) + EPS);
    if (l == DEPTH - 1) {
        f32x4* orow = (f32x4*)(p.out + (size_t)tok * D) + lane;
#pragma unroll
        for (int j = 0; j < 4; ++j) orow[64 * j] = v[j] * r * gfv[j];
    } else {
        u32x2* xr = (u32x2*)((bf16_t*)(ws + WS_XB) + (size_t)tok * D) + lane;
        u32x2 w[4]; float s2 = 0.f, am = 0.f;
#pragma unroll
        for (int j = 0; j < 4; ++j) { w[j].x = pk2(v[j].x, v[j].y); w[j].y = pk2(v[j].z, v[j].w);
            const float a0 = __uint_as_float(w[j].x << 16), a1 = __uint_as_float(w[j].x & 0xffff0000u), a2 = __uint_as_float(w[j].y << 16), a3 = __uint_as_float(w[j].y & 0xffff0000u); s2 += (a0 * a0 + a1 * a1) + (a2 * a2 + a3 * a3); xr[64 * j] = w[j];
            am = fmaxf(am, fmaxf(fmaxf(fabsf(a0), fabsf(a1)), fmaxf(fabsf(a2), fabsf(a3)))); }
        s2 = wave_sum(s2); am = fmaxf(wave_max(am), 1e-30f); const float inv = 127.f / am;
        unsigned* q = (unsigned*)(ws + WS_XB8 + (size_t)tok * D) + lane;
#pragma unroll
        for (int j = 0; j < 4; ++j) q[64 * j] = pk4_i8(__uint_as_float(w[j].x << 16) * inv, __uint_as_float(w[j].x & 0xffff0000u) * inv, __uint_as_float(w[j].y << 16) * inv, __uint_as_float(w[j].y & 0xffff0000u) * inv);
        if (lane == 0) ((float*)(ws + WS_RS))[tok] = am * (1.f / 127.f) / sqrtf(s2 * (1.f / D) + EPS);
    }
}
__device__ __forceinline__ void combine_phase(const Params& p, int l, int gw, int ngw, int lane) {
    const unsigned char* ws = p.ws; const int* pos = (const int*)(ws + WS_POS);
    constexpr int CB = 4;
    f32x4 gfv[4];
#pragma unroll
    for (int j = 0; j < 4; ++j) gfv[j] = (l == DEPTH - 1) ? ((const f32x4*)p.in[18] + lane)[64 * j] : (f32x4){0.f, 0.f, 0.f, 0.f};
    int pp[CB][2];
#pragma unroll
    for (int k = 0; k < CB; ++k) { const int tk = gw + k * ngw; pp[k][0] = 0; pp[k][1] = 0; if (tk < NTOK) { pp[k][0] = pos[tk * 2]; pp[k][1] = pos[tk * 2 + 1]; } }
#pragma unroll 1
    for (int tb = gw; tb < NTOK; tb += CB * ngw) {
#pragma unroll
        for (int k = 0; k < CB; ++k) asm volatile("" : "+v"(pp[k][0]), "+v"(pp[k][1]));
        int pn[CB][2];
#pragma unroll
        for (int k = 0; k < CB; ++k) { const int tn = tb + (CB + k) * ngw; pn[k][0] = 0; pn[k][1] = 0; if (tn < NTOK) { pn[k][0] = pos[tn * 2]; pn[k][1] = pos[tn * 2 + 1]; } }
        CombRows R[CB];
#pragma unroll
        for (int k = 0; k < CB; ++k) { const int tk = tb + k * ngw; if (tk < NTOK) comb_load(R[k], ws, tk, pp[k][0], pp[k][1], lane); }
        __builtin_amdgcn_sched_barrier(0);
#pragma unroll
        for (int k = 0; k < CB; ++k) { const int tk = tb + k * ngw; if (tk < NTOK) comb_finish(p, R[k], gfv, l, tk, lane); }
#pragma unroll
        for (int k = 0; k < CB; ++k) { pp[k][0] = pn[k][0]; pp[k][1] = pn[k][1]; }
    }
}

#define XB_TMO      128
#define XB_XCNT(j)  (256  + 64 * (j))
#define XB_XSUB(j)  (1280 + 64 * (j))
#define XB_XGEN(j)  (2304 + 64 * (j))
#define XB_TOP      3328
#define XB_TOPGEN   3392
#define XCD_BAR_WORDS 3456
#define XB_SPIN_CAP (1u << 18)
__device__ __forceinline__ unsigned xb_ld(unsigned* p)              { return __hip_atomic_load(p, __ATOMIC_RELAXED, __HIP_MEMORY_SCOPE_AGENT); }
__device__ __forceinline__ unsigned xb_add(unsigned* p, unsigned v) { return __hip_atomic_fetch_add(p, v, __ATOMIC_RELAXED, __HIP_MEMORY_SCOPE_AGENT); }
__device__ __forceinline__ unsigned xb_xcc_id() { return (unsigned)__builtin_amdgcn_s_getreg((3 << 11) | 20) & 0xFu; }
#define XB_SPIN(cond, bar) do { unsigned _sp = 0; while (cond) { __builtin_amdgcn_s_sleep(1); \
    if ((++_sp & 255u) == 0u) { if (xb_ld(&(bar)[XB_TMO])) break; if (_sp > XB_SPIN_CAP) { atomicAdd(&(bar)[XB_TMO], 1u); break; } } } } while (0)
struct XcdBarrier { unsigned* bar; unsigned x; volatile LAS unsigned* st; };
__device__ __forceinline__ XcdBarrier xcd_barrier_post(unsigned* bar, volatile LAS unsigned* st) {
    XcdBarrier b; b.bar = bar; b.x = xb_xcc_id(); b.st = st;
    if (threadIdx.x == 0) (void)xb_add(&bar[XB_XCNT(b.x)], 1u);
    return b;
}
__device__ __forceinline__ void xcd_barrier_complete(unsigned* bar, unsigned x, unsigned& nloc, unsigned& nx) {
    const unsigned G = gridDim.x * gridDim.y * gridDim.z;
    unsigned sum, cnt, mine, sp = 0u;
    for (;;) {
        sum = 0u; cnt = 0u; mine = 0u;
#pragma unroll
        for (unsigned j = 0; j < 16; ++j) { const unsigned c = xb_ld(&bar[XB_XCNT(j)]); sum += c; cnt += (c > 0u) ? 1u : 0u; mine = (j == x) ? c : mine; }
        if (sum == G) break;
        __builtin_amdgcn_s_sleep(1);
        if ((++sp & 255u) == 0u) { if (xb_ld(&bar[XB_TMO])) break; if (sp > XB_SPIN_CAP) { atomicAdd(&bar[XB_TMO], 1u); break; } }
    }
    nloc = mine > 0u ? mine : 1u; nx = cnt > 0u ? cnt : 1u;
}
__device__ __forceinline__ void xcd_barrier(const XcdBarrier& b) {
    asm volatile("s_waitcnt vmcnt(0)" ::: "memory");
    __syncthreads();
    if (threadIdx.x == 0) {
        unsigned* bar = b.bar;
        __builtin_amdgcn_s_waitcnt(0);
        unsigned nloc = b.st[0], nx = b.st[1];
        if (nloc == 0u) { xcd_barrier_complete(bar, b.x, nloc, nx); b.st[0] = nloc; b.st[1] = nx; }
        const unsigned old = xb_add(&bar[XB_XSUB(b.x)], 1u);
        const unsigned gen = old / nloc;
        if (old + 1u == (gen + 1u) * nloc) {
            __builtin_amdgcn_fence(__ATOMIC_RELEASE, "agent");
            asm volatile("s_waitcnt vmcnt(0)" ::: "memory");
            const unsigned og = xb_add(&bar[XB_TOP], 1u);
            const unsigned tg = og / nx;
            if (og + 1u == (tg + 1u) * nx) xb_add(&bar[XB_TOPGEN], 1u);
            else XB_SPIN(xb_ld(&bar[XB_TOPGEN]) == tg, bar);
            __builtin_amdgcn_fence(__ATOMIC_ACQUIRE, "agent");
            xb_add(&bar[XB_XGEN(b.x)], 1u);
            asm volatile("s_waitcnt vmcnt(0)" ::: "memory");
        } else {
            XB_SPIN(xb_ld(&bar[XB_XGEN(b.x)]) == gen, bar);
            __builtin_amdgcn_fence(__ATOMIC_ACQUIRE, "agent");
            asm volatile("s_waitcnt vmcnt(0)" ::: "memory");
        }
    }
    __syncthreads();
}

constexpr size_t WS_BAR = 16384;
typedef const __attribute__((address_space(4))) Params* KParamsPtr;
__device__ __forceinline__ KParamsPtr kparams() { KParamsPtr kp = (KParamsPtr)__builtin_amdgcn_kernarg_segment_ptr(); asm volatile("" : "+s"(kp)); return kp; }
#define PP (*(const Params*)kparams())
__global__ void __launch_bounds__(NTHREADS, 2) k_mega(Params p_unused) {
    extern __shared__ __attribute__((aligned(16))) unsigned char lds_raw[];
    LAS unsigned char* lds = (LAS unsigned char*)lds_raw;
    volatile LAS unsigned* bst = (volatile LAS unsigned*)(lds + LDS_BYTES - 64);
    if (threadIdx.x == 0) { bst[0] = 0u; bst[1] = 0u; }
    __syncthreads();
    (void)xcd_barrier_post((unsigned*)(PP.ws + WS_BAR), bst);
#define GRID_BAR() xcd_barrier(XcdBarrier{(unsigned*)(PP.ws + WS_BAR), xb_xcc_id(), bst})
    const int b0 = blockIdx.x, nb = gridDim.x, ngw = nb * 8;
#define MK_LANE ({ int t_ = threadIdx.x; asm volatile("" : "+v"(t_)); t_ & 63; })
#define MK_GW ({ int t_ = threadIdx.x; asm volatile("" : "+v"(t_)); b0 * 8 + (t_ >> 6); })
    setup_phase(PP, b0, nb);
    wmax_phase(PP, b0, nb);
    convert_mem_phase(PP, (LAS float*)lds, b0, nb);
    prep_phase(PP, MK_GW, ngw, MK_LANE);
    GRID_BAR();
    if (b0 < 64) {
#pragma unroll 1
        for (int u = b0; u < 64; u += (nb > 64 ? 64 : nb)) phase_memkv(PP, lds, u >> 5, u & 31, 32);
    }
    { constexpr int NCV = 2 * CT_LAYER, N1 = 4032; const bool wsplit = nb > 128;
      const int ci0 = !wsplit ? b0 : (b0 < 64 ? N1 + b0 : b0 - 64), cst = !wsplit ? nb : (b0 < 64 ? 64 : nb - 64), chi = (wsplit && b0 >= 64) ? N1 : NCV;
      convert_phase(PP, (LAS float*)lds, ci0, cst, chi); }
    GRID_BAR();
#pragma unroll 1
    for (int l = 0; l < DEPTH; ++l) {
#pragma unroll 1
        for (int half = 0; half < 2; ++half) {
            phase_mix(PP, lds, l, half);
            GRID_BAR();
            phase_hgrnA(PP, lds, b0, nb);
            GRID_BAR();
            phase_diff(PP, lds, l, half);
            GRID_BAR();
            phase_gates(PP, lds, l, half);
            phase_merge(PP, lds, l, half);
            GRID_BAR();
        }
        phase_out(PP, lds, l);
        GRID_BAR();
        route_phase(PP, l, lds, b0, nb);
        GRID_BAR();
        lists_phase(PP, (LAS int*)lds, b0, nb);
        GRID_BAR();
        phase_gateup(PP, lds, l);
        phase_down(PP, lds, l);
        GRID_BAR();
        combine_phase(PP, l, MK_GW, ngw, MK_LANE);
        if (l + 1 < DEPTH) GRID_BAR();
    }
}

extern "C" void kernel_launch(void* const* d_in, const int* in_sizes, int n_in, void* d_out, int out_size, void* d_ws, size_t ws_size, hipStream_t stream) {
    static int grid = 0;
    if (grid == 0) {
        if (n_in != 19 || ws_size < WS_END) { fprintf(stderr, "kernel_launch: unexpected inputs (n_in %d, ws %zu)\n", n_in, ws_size); grid = -1; return; }
        int dev = 0, cus = 0, per_cu = 0;
        if (hipGetDevice(&dev) != hipSuccess || hipDeviceGetAttribute(&cus, hipDeviceAttributeMultiprocessorCount, dev) != hipSuccess) { grid = -1; return; }
        if (hipFuncSetAttribute((const void*)k_mega, hipFuncAttributeMaxDynamicSharedMemorySize, LDS_BYTES) != hipSuccess) { fprintf(stderr, "kernel_launch: hipFuncSetAttribute failed\n"); grid = -1; return; }
        if (hipOccupancyMaxActiveBlocksPerMultiprocessor(&per_cu, (const void*)k_mega, NTHREADS, LDS_BYTES) != hipSuccess || per_cu < 1) { fprintf(stderr, "kernel_launch: occupancy query reports %d\n", per_cu); }
        (void)hipGetLastError();
        grid = cus;
    }
    if (grid < 0) return;
    Params p{};
    for (int i = 0; i < 19; ++i) p.in[i] = (const float*)d_in[i];
    p.out = (float*)d_out; p.ws = (unsigned char*)d_ws; p.l = 0; p.half = 0;
    (void)hipMemsetAsync(d_ws, 0, 1 * MiB, stream);
    hipLaunchKernelGGL(k_mega, dim3(grid), dim3(NTHREADS), LDS_BYTES, stream, p);
}
```

```cpp
#include <hip/hip_runtime.h>
#include <cstdio>
#include <cstdint>

#define LAS __attribute__((address_space(3)))
typedef unsigned short bf16_t;
typedef short bf16x8 __attribute__((ext_vector_type(8)));
typedef float f32x4 __attribute__((ext_vector_type(4)));
typedef float f32x2 __attribute__((ext_vector_type(2)));
typedef unsigned u32x4 __attribute__((ext_vector_type(4)));
typedef unsigned u32x2 __attribute__((ext_vector_type(2)));

constexpr int D = 1024, NBATCH = 8, SEQ = 4096, NTOK = NBATCH * SEQ, DEPTH = 2, MEMLEN = 256, NMEM = NBATCH * MEMLEN;
constexpr int HT = NTOK / 2;
constexpr int HB = NBATCH / 2;
constexpr int NE = 16, DE = 512;
constexpr int IN_TOTAL = 7168, MIXW = 4096, GATEW = 3072;
constexpr float EPS = 1e-6f;
constexpr float LOG2E = 1.4426950408889634f;
constexpr int MAXROWS = 65536 + NE * 256;

constexpr size_t MiB = 1u << 20;
constexpr size_t WS_CTL = 0;
constexpr size_t WS_LAM = 1 * MiB;
constexpr size_t WS_LBS = 1 * MiB + 4096;
constexpr size_t WS_WRT = 1 * MiB + 65536;
constexpr size_t WS_RS = 1 * MiB + 262144;
constexpr size_t WS_RSMEM = 1 * MiB + 393216;
constexpr size_t WS_TOKINFO = 1 * MiB + 524288;
constexpr size_t WS_CHUNKCNT = 2 * MiB;
constexpr size_t WS_TILEEXP = 2 * MiB + 16384;
constexpr size_t WS_NTILES = 2 * MiB + 20480;
constexpr size_t WS_ROWTOK = 2 * MiB + 65536;
constexpr size_t WS_ROWWT = 2 * MiB + 65536 + 327680;
constexpr size_t WS_ROWRS = 2 * MiB + 65536 + 2 * 327680;
constexpr size_t WS_POS = 3 * MiB + 524288;
constexpr size_t WS_MEMB = 4 * MiB;
constexpr size_t WS_XB = 8 * MiB;
constexpr size_t WS_BIG = 72 * MiB;
constexpr size_t WS_ST = 328 * MiB;
constexpr size_t WS_MKV = 344 * MiB;
constexpr size_t WS_WMIX = 352 * MiB;
constexpr size_t WMIX_LAYER = 21 * MiB, WMIX_BR = 14 * MiB, WMIX_OUT = 17 * MiB, WMIX_MEM = 19 * MiB;
constexpr size_t WS_WMOE = 394 * MiB;
constexpr size_t WMOE_LAYER = 24 * MiB, WMOE_D = 16 * MiB;
constexpr size_t WS_XB8 = 442 * MiB;
constexpr float YS8_SCALE = 16.f;
constexpr float W8_SCALE = 64.f, ACT8_SCALE = 8.f;
constexpr size_t WS_END = 490 * MiB;
constexpr size_t WS_KM2 = 262144;
constexpr size_t WS_WMAX = 393216;
constexpr size_t WS_WSC = 1 * MiB + 409600;
constexpr size_t WS_HGCNT = 196608, WS_SPINTMO = 10240;
constexpr size_t BG_PB = 0;
constexpr size_t PB_STRIDE = (size_t)HT * 512 * 2;
constexpr size_t BG_LOGF = 112 * MiB;
constexpr size_t BG_YCAT = 144 * MiB;
constexpr size_t BG_GATES = 0;
constexpr size_t BG_MERGED = 192 * MiB;
constexpr size_t BG_ACT = 0;
constexpr size_t BG_YSLOT = 68 * MiB;
enum { SL_QA = 0, SL_KA = 1, SL_VA = 2, SL_HQ = 3, SL_HV = 4, SL_HG = 5, SL_CQ = 6 };

struct Params {
    const float* in[19];
    float* out;
    unsigned char* ws;
    int l, half;
};

__device__ __forceinline__ float bf2f(bf16_t b) { return __uint_as_float(((unsigned)b) << 16); }
__device__ __forceinline__ unsigned f2bf(float f) { unsigned u = __float_as_uint(f); return (u + 0x7fffu + ((u >> 16) & 1u)) >> 16; }
typedef __bf16 bf16x2_t __attribute__((ext_vector_type(2)));
__device__ __forceinline__ unsigned cvt_pk_bf16(float lo, float hi) { const f32x2 v = {lo, hi}; return __builtin_bit_cast(unsigned, __builtin_convertvector(v, bf16x2_t)); }
__device__ __forceinline__ unsigned pk2(float lo, float hi) { return cvt_pk_bf16(lo, hi); }
__device__ __forceinline__ unsigned pk4_fp8(float a, float b, float c, float d) { int w = 0; w = __builtin_amdgcn_cvt_pk_fp8_f32(a, b, w, false); w = __builtin_amdgcn_cvt_pk_fp8_f32(c, d, w, true); return (unsigned)w; }
__device__ __forceinline__ unsigned pk4_i8(float a, float b, float c, float d) {
    const int ia = __float2int_rn(fminf(fmaxf(a, -127.f), 127.f)), ib = __float2int_rn(fminf(fmaxf(b, -127.f), 127.f)), ic = __float2int_rn(fminf(fmaxf(c, -127.f), 127.f)), id = __float2int_rn(fminf(fmaxf(d, -127.f), 127.f));
    return (unsigned)(ia & 255) | ((unsigned)(ib & 255) << 8) | ((unsigned)(ic & 255) << 16) | ((unsigned)id << 24); }
__device__ __forceinline__ float fsigmoid(float z) { return __builtin_amdgcn_rcpf(1.f + __expf(-z)); }
__device__ __forceinline__ float fsilu(float z) { return z * fsigmoid(z); }
__device__ __forceinline__ void lds_barrier() { asm volatile("s_waitcnt lgkmcnt(0)" ::: "memory"); __builtin_amdgcn_s_barrier(); asm volatile("" ::: "memory"); }
__device__ __forceinline__ float wave_sum(float v) {
#pragma unroll
    for (int o = 1; o < 64; o <<= 1) v += __shfl_xor(v, o);
    return v;
}
__device__ __forceinline__ float wave_max(float v) {
#pragma unroll
    for (int o = 1; o < 64; o <<= 1) v = fmaxf(v, __shfl_xor(v, o));
    return v;
}

namespace pg8 {
constexpr int BM = 256, BK = 64, HALF = 128, HTB = HALF * BK * 2, STAGE_BYTES = 8 * HTB, NXCD = 8, WGM = 8;
__host__ __device__ __forceinline__ int lds_byte(int r, int c) { const int st = (r >> 4) * 2 + (c >> 5), rr = r & 15, cc = c & 31, ob = rr * 64 + cc * 2; return st * 1024 + (ob ^ (((ob >> 9) & 1) << 5)); }
__host__ __device__ __forceinline__ void stage_rc(int b, int& R, int& C) { const int st = b / 1024, sb = b % 1024, swz = sb ^ (((sb >> 9) & 1) << 5); R = (st >> 1) * 16 + swz / 64; C = (st & 1) * 32 + (swz % 64) / 2; }
__host__ __device__ __forceinline__ int perm32(int rho) { const int n = rho >> 4, i = rho & 15; return 8 * (i >> 2) + 4 * n + (i & 3); }

struct Unit { int pm, pn; };
struct Gemm { const bf16_t* A; const bf16_t* Bt; int K; const float* cs; };

struct StaticOrder {
    static constexpr bool GATHER = false;
    int nM, nN, nwg, G, c;
    __device__ void init(int M, int N, int G_, int c_) { nM = M / BM; nN = N / BM; nwg = nM * nN; G = G_; c = c_; }
    __device__ bool next(int i, Unit& u) const {
        const long L = (long)i * G + c; if (L >= nwg) return false;
        int wgid = (int)L; { const int q = nwg / NXCD, r = nwg % NXCD, xcd = wgid % NXCD, off = wgid / NXCD; wgid = (xcd < r ? xcd * (q + 1) : r * (q + 1) + (xcd - r) * q) + off; }
        const int nig = WGM * nN, gid = wgid / nig, fm = gid * WGM, gsz = (nM - fm) < WGM ? (nM - fm) : WGM;
        u.pm = fm + ((wgid % nig) % gsz); u.pn = (wgid % nig) / gsz; return true;
    }
    __device__ __forceinline__ size_t b_off(const Unit& u, size_t tstep) const { return (size_t)u.pn * tstep; }
    __device__ __forceinline__ int b_key(const Unit&) const { return 0; }
    __device__ __forceinline__ size_t b_off_k(int, const Unit& u, size_t tstep) const { return (size_t)u.pn * tstep; }
    __device__ __forceinline__ int row(const Unit&, int) const { return 0; }
};
struct GatesOfMerge : StaticOrder {
    __device__ bool next(int i, Unit& u) const { Unit mu; if (!StaticOrder::next(i / 3, mu)) return false; u.pm = mu.pm; u.pn = mu.pn + 4 * (i % 3); return true; }
};
template <bool GATH> struct MoeOrder : StaticOrder {
    static constexpr bool GATHER = GATH;
    const int* tile_exp; const int* rowtok; size_t estride;
    __device__ __forceinline__ size_t b_off(const Unit& u, size_t tstep) const { return (size_t)tile_exp[u.pm] * estride + (size_t)u.pn * tstep; }
    __device__ __forceinline__ int b_key(const Unit& u) const { return tile_exp[u.pm]; }
    __device__ __forceinline__ size_t b_off_k(int key, const Unit& u, size_t tstep) const { return (size_t)key * estride + (size_t)u.pn * tstep; }
    __device__ __forceinline__ int row(const Unit& u, int r) const { return rowtok[u.pm * BM + r]; }
};

typedef f32x4 Acc[2][2][4][2];

__device__ __forceinline__ const char* uni_ptr(const char* p) { const unsigned long long v = (unsigned long long)p; const unsigned lo = __builtin_amdgcn_readfirstlane((unsigned)v), hi = __builtin_amdgcn_readfirstlane((unsigned)(v >> 32)); return (const char*)(((unsigned long long)hi << 32) | lo); }
template <class Epi, class Sched, bool ALIGN_EPI, int QM = 0>
__device__ __forceinline__ void gemm_phase(LAS unsigned char* lds, const Gemm g, const Sched& S, const Epi& E) {
    constexpr bool GATHER = Sched::GATHER, FP8 = QM == 1, I8 = QM == 2; static_assert(!I8 || Epi::PERM, "int8 flavour: PERM column map");
    int tid = threadIdx.x; asm volatile("" : "+v"(tid));
    const int wid = __builtin_amdgcn_readfirstlane(tid >> 6), lane = tid & 63, wr = wid >> 2, wc = wid & 3, fr = lane & 15, fq = lane >> 4;
    const int K = g.K, nt = K / BK;
    unsigned voffB[2]; int Rr[2], Cc[2];
#pragma unroll
    for (int i = 0; i < 2; ++i) { int R, C; stage_rc(tid * 16 + i * 8192, R, C); Rr[i] = R; Cc[i] = C; const int Rb = Epi::PERM ? ((R & ~31) + perm32(R & 31)) : R;
        voffB[i] = (unsigned)(Rb * K + C) * 2u; }
    const size_t kstep = (size_t)(BK * 2);
    const size_t hstep = (size_t)HALF * K * 2;
    const size_t tstep = 2 * hstep;
    const unsigned ldsw = (unsigned)wid * 1024u;
    const int aoff = lds_byte(wr * 64 + fr, fq * 8), boff = lds_byte(wc * 32 + fr, fq * 8);
#define PG8_SA(b, h) (((b) * 2 + (h)) * HTB)
#define PG8_SB(b, h) ((4 + (b) * 2 + (h)) * HTB)
#define PG8_STAGE(bufoff, gbase, voff) do { _Pragma("unroll") for (int _i = 0; _i < 2; ++_i) \
        __builtin_amdgcn_global_load_lds((const unsigned*)((const char*)(gbase) + (voff)[_i]), (LAS unsigned*)(lds + (bufoff) + ldsw + _i * 8192), 16, 0, 0); } while (0)
#define PG8_STAGEA(bufoff, gbase, v, h) do { _Pragma("unroll") for (int _i = 0; _i < 2; ++_i) \
        __builtin_amdgcn_global_load_lds((const unsigned*)((const char*)(gbase) + (v)[h][_i]), (LAS unsigned*)(lds + (bufoff) + ldsw + _i * 8192), 16, 0, 0); } while (0)
#define PG8_SETA(v, u) do { _Pragma("unroll") for (int _h = 0; _h < 2; ++_h) _Pragma("unroll") for (int _i = 0; _i < 2; ++_i) \
        (v)[_h][_i] = GATHER ? (unsigned)(S.row((u), _h * HALF + Rr[_i]) * K + Cc[_i]) * 2u : (unsigned)((_h * HALF + Rr[_i]) * K + Cc[_i]) * 2u; \
        asm volatile("" : "+v"((v)[0][0]), "+v"((v)[0][1]), "+v"((v)[1][0]), "+v"((v)[1][1])); } while (0)
    typedef int v8i_ __attribute__((ext_vector_type(8))); typedef int v4i_ __attribute__((ext_vector_type(4)));
#define PG8_LD2(p_) (__builtin_shufflevector(*(const LAS v4i_*)(p_), *(const LAS v4i_*)((p_) + 1024), 0, 1, 2, 3, 4, 5, 6, 7))
#define PG8_LDA(dst, b, h) do { _Pragma("unroll") for (int m = 0; m < 4; ++m) { if constexpr (FP8) dst##8[m] = PG8_LD2(lds + PG8_SA(b, h) + aoff + m * 2048); else { _Pragma("unroll") for (int k = 0; k < 2; ++k) dst[m][k] = *(const LAS bf16x8*)(lds + PG8_SA(b, h) + aoff + m * 2048 + k * 1024); } } } while (0)
#define PG8_LDB(dst, b, h) do { _Pragma("unroll") for (int n = 0; n < 2; ++n) { if constexpr (FP8) dst##8[n] = PG8_LD2(lds + PG8_SB(b, h) + boff + n * 2048); else { _Pragma("unroll") for (int k = 0; k < 2; ++k) dst[n][k] = *(const LAS bf16x8*)(lds + PG8_SB(b, h) + boff + n * 2048 + k * 1024); } } } while (0)
#define PG8_MMA(ai, bj, At, Bt) do { __builtin_amdgcn_s_setprio(1); _Pragma("unroll") for (int m = 0; m < 4; ++m) _Pragma("unroll") for (int n = 0; n < 2; ++n) { \
        if constexpr (FP8) { asm volatile("v_mfma_scale_f32_16x16x128_f8f6f4 %0, %1, %2, %0, %3, %3 op_sel_hi:[0,0,0]" : "+v"(acc[ai][bj][m][n]) : "v"(Bt##8[n]), "v"(At##8[m]), "v"(mx_one)); } \
        else if constexpr (I8) { _Pragma("unroll") for (int k = 0; k < 2; ++k) acc[ai][bj][m][n] = __builtin_bit_cast(f32x4, __builtin_amdgcn_mfma_i32_16x16x64_i8(__builtin_bit_cast(v4i_, Bt[n][k]), __builtin_bit_cast(v4i_, At[m][k]), __builtin_bit_cast(v4i_, acc[ai][bj][m][n]), 0, 0, 0)); } \
        else { _Pragma("unroll") for (int k = 0; k < 2; ++k) acc[ai][bj][m][n] = __builtin_amdgcn_mfma_f32_16x16x32_bf16(Bt[n][k], At[m][k], acc[ai][bj][m][n], 0, 0, 0); } } \
        __builtin_amdgcn_s_setprio(0); } while (0)
#define PG8_WAIT_V(n) asm volatile("s_waitcnt vmcnt(" #n ")" ::: "memory")
#define PG8_WAIT_L(n) asm volatile("s_waitcnt lgkmcnt(" #n ")" ::: "memory")
#define PG8_BAR __builtin_amdgcn_s_barrier()
#define PG8_SCHED __builtin_amdgcn_sched_barrier(0)
    Unit cur, nxt; int ui = 0;
    if (!S.next(0, cur)) return;
    Acc acc;
#pragma unroll
    for (int a = 0; a < 2; ++a)
#pragma unroll
        for (int b = 0; b < 2; ++b)
#pragma unroll
            for (int m = 0; m < 4; ++m)
#pragma unroll
                for (int n = 0; n < 2; ++n) acc[a][b][m][n] = (f32x4){0.f, 0.f, 0.f, 0.f};
    bf16x8 At[4][2], B0[2][2], B1[2][2]; v8i_ At8[4], B08[2], B18[2];
    int mx_one = 0x7f7f7f7f; asm volatile("" : "+v"(mx_one));
    unsigned vA[2][2], vN[2][2];
    PG8_SETA(vA, cur);
    const char* cA = (const char*)g.A + (GATHER ? (size_t)0 : (size_t)cur.pm * tstep); const char* cB = (const char*)g.Bt + S.b_off(cur, tstep);
    PG8_STAGE(PG8_SB(0, 0), cB, voffB); PG8_STAGE(PG8_SB(0, 1), cB + hstep, voffB); PG8_STAGEA(PG8_SA(0, 0), cA, vA, 0); PG8_STAGEA(PG8_SA(0, 1), cA, vA, 1);
    if (wr == 1) PG8_BAR;
    PG8_WAIT_V(2); PG8_BAR;
    PG8_STAGE(PG8_SB(1, 0), cB + kstep, voffB); PG8_STAGEA(PG8_SA(1, 0), cA + kstep, vA, 0); PG8_STAGE(PG8_SB(1, 1), cB + hstep + kstep, voffB);
    PG8_WAIT_V(6); PG8_BAR;
    for (;;) {
        const bool has_next = S.next(ui + 1, nxt);
        const char* nA = has_next ? (const char*)g.A + (GATHER ? (size_t)0 : (size_t)nxt.pm * tstep) : cA; const char* nB = cB;
        int keyN = 0;
        if (has_next) { keyN = S.b_key(nxt);
            if (GATHER) {
#pragma unroll
                for (int h = 0; h < 2; ++h)
#pragma unroll
                    for (int i = 0; i < 2; ++i) vN[h][i] = (unsigned)S.row(nxt, h * HALF + Rr[i]); } }
#pragma unroll 1
        for (int t = 0; t < nt; t += 2) {
            const bool last = (t == nt - 2);
            if constexpr (Epi::MIDK) { if (t == Epi::MID1 || t == Epi::MID2) E.mid(acc, cur, t, wr, wc, fr, fq); }
            const char* a1 = cA + (size_t)(t + 1) * kstep;
            if (last) {
                if (has_next) nB = (const char*)g.Bt + S.b_off_k(__builtin_amdgcn_readfirstlane(keyN), nxt, tstep);
                if (GATHER) {
                    if (has_next) { asm volatile("" : "+v"(vN[0][0]), "+v"(vN[0][1]), "+v"(vN[1][0]), "+v"(vN[1][1])); }
#pragma unroll
                    for (int h = 0; h < 2; ++h)
#pragma unroll
                        for (int i = 0; i < 2; ++i) vN[h][i] = has_next ? (unsigned)((int)vN[h][i] * K + Cc[i]) * 2u : vA[h][i]; }
            }
            const char* a2 = last ? nA : cA + (size_t)(t + 2) * kstep; const char* b2 = last ? nB : cB + (size_t)(t + 2) * kstep;
            const char* a3 = a2 + kstep; const char* b3 = b2 + kstep;
            unsigned w2[2][2];
#pragma unroll
            for (int h = 0; h < 2; ++h)
#pragma unroll
                for (int i = 0; i < 2; ++i) w2[h][i] = (GATHER && last) ? vN[h][i] : vA[h][i];
            PG8_LDB(B0, 0, 0); PG8_LDB(B1, 0, 1); PG8_SCHED; PG8_LDA(At, 0, 0); PG8_STAGEA(PG8_SA(1, 1), a1, vA, 1);
            PG8_WAIT_V(8); PG8_WAIT_L(0); PG8_BAR; PG8_MMA(0, 0, At, B0); PG8_MMA(0, 1, At, B1); PG8_BAR; PG8_SCHED;
            PG8_LDA(At, 0, 1); PG8_STAGE(PG8_SB(0, 0), b2, voffB); PG8_STAGE(PG8_SB(0, 1), b2 + hstep, voffB); PG8_STAGEA(PG8_SA(0, 0), a2, w2, 0);
            PG8_WAIT_V(8); PG8_WAIT_L(0); PG8_BAR; PG8_MMA(1, 0, At, B0); PG8_MMA(1, 1, At, B1); PG8_BAR; PG8_SCHED;
            PG8_LDB(B0, 1, 0); PG8_LDB(B1, 1, 1); PG8_SCHED; PG8_LDA(At, 1, 0); PG8_STAGEA(PG8_SA(0, 1), a2, w2, 1);
            PG8_WAIT_V(8); PG8_WAIT_L(0); PG8_BAR; PG8_MMA(0, 0, At, B0); PG8_MMA(0, 1, At, B1); PG8_BAR; PG8_SCHED;
            PG8_LDA(At, 1, 1); PG8_STAGE(PG8_SB(1, 0), b3, voffB); PG8_STAGE(PG8_SB(1, 1), b3 + hstep, voffB); PG8_STAGEA(PG8_SA(1, 0), a3, w2, 0);
            PG8_WAIT_V(8); PG8_WAIT_L(0); PG8_BAR; PG8_MMA(1, 0, At, B0); PG8_MMA(1, 1, At, B1); PG8_BAR; PG8_SCHED;
        }
        if constexpr (ALIGN_EPI) { if (wr == 0) PG8_BAR; }
        if constexpr (FP8) asm volatile("s_nop 15\n\ts_nop 15\n\ts_nop 7" ::: "memory");
        if constexpr (I8) {
#pragma unroll
            for (int bj = 0; bj < 2; ++bj)
#pragma unroll
                for (int n = 0; n < 2; ++n) { const f32x4 c = *(const f32x4*)(g.cs + cur.pn * BM + bj * HALF + wc * 32 + 8 * fq + 4 * n);
#pragma unroll
                    for (int ai = 0; ai < 2; ++ai)
#pragma unroll
                        for (int m = 0; m < 4; ++m)
#pragma unroll
                            for (int j = 0; j < 4; ++j) acc[ai][bj][m][n][j] = (float)__float_as_int(acc[ai][bj][m][n][j]) * c[j]; } }
        E(acc, cur, wr, wc, fr, fq);
        if (!has_next) break;
#pragma unroll
        for (int a = 0; a < 2; ++a)
#pragma unroll
            for (int b = 0; b < 2; ++b)
#pragma unroll
                for (int m = 0; m < 4; ++m)
#pragma unroll
                    for (int n = 0; n < 2; ++n) acc[a][b][m][n] = (f32x4){0.f, 0.f, 0.f, 0.f};
        cur = nxt; cA = nA; cB = nB; ++ui;
        if (GATHER) {
#pragma unroll
            for (int h = 0; h < 2; ++h)
#pragma unroll
                for (int i = 0; i < 2; ++i) vA[h][i] = vN[h][i]; }
        if constexpr (ALIGN_EPI) { if (wr == 1) PG8_BAR; }
    }
    PG8_WAIT_V(0);
    if constexpr (!ALIGN_EPI) { if (wr == 0) PG8_BAR; }
    PG8_BAR;
#undef PG8_SA
#undef PG8_SB
#undef PG8_STAGE
#undef PG8_STAGEA
#undef PG8_SETA
#undef PG8_LDA
#undef PG8_LD2
#undef PG8_LDB
#undef PG8_MMA
#undef PG8_WAIT_V
#undef PG8_WAIT_L
#undef PG8_BAR
#undef PG8_SCHED
}

__device__ __forceinline__ u32x4 pack8(const f32x4& a, const f32x4& b) { u32x4 w; w.x = cvt_pk_bf16(a[0], a[1]); w.y = cvt_pk_bf16(a[2], a[3]); w.z = cvt_pk_bf16(b[0], b[1]); w.w = cvt_pk_bf16(b[2], b[3]); return w; }

struct EpiMix {
    static constexpr bool PERM = true, MIDK = false; static constexpr int MID1 = -1, MID2 = -1;
    bf16_t* pb; _Float16* logf; const float* rs; const float* lb; float qscale, cqscale; unsigned* kmt;
    __device__ __forceinline__ void operator()(const Acc& acc, const Unit& u, int wr, int wc, int fr, int fq) const {
        float kmx[2][2] = {{0.f, 0.f}, {0.f, 0.f}};
        const int type = u.pn >> 1; const int colb = (u.pn & 1) * 256 + wc * 32 + 8 * fq;
        int slot = 0; float sc = 1.f;
        switch (type) { case 0: slot = SL_QA; sc = qscale; break; case 1: slot = SL_KA; break; case 2: slot = SL_VA; break; case 3: slot = SL_HQ; break;
                        case 5: slot = SL_HV; break; case 6: slot = SL_HG; break; case 7: slot = SL_CQ; sc = cqscale; break; default: break; }
        bf16_t* ob = pb + (size_t)slot * HT * 512;
        float rv[2][4];
#pragma unroll
        for (int ai = 0; ai < 2; ++ai)
#pragma unroll
            for (int m = 0; m < 4; ++m) rv[ai][m] = rs[u.pm * BM + ai * HALF + wr * 64 + m * 16 + fr];
        f32x4 lbv[2][2] = {{(f32x4){0.f, 0.f, 0.f, 0.f}, (f32x4){0.f, 0.f, 0.f, 0.f}}, {(f32x4){0.f, 0.f, 0.f, 0.f}, (f32x4){0.f, 0.f, 0.f, 0.f}}};
        if (type == 4) {
#pragma unroll
            for (int bj = 0; bj < 2; ++bj) { lbv[bj][0] = *(const f32x4*)(lb + colb + bj * HALF); lbv[bj][1] = *(const f32x4*)(lb + colb + bj * HALF + 4); } }
#pragma unroll
        for (int ai = 0; ai < 2; ++ai)
#pragma unroll
            for (int m = 0; m < 4; ++m) {
                const int row = u.pm * BM + ai * HALF + wr * 64 + m * 16 + fr; const float r = rv[ai][m];
#pragma unroll
                for (int bj = 0; bj < 2; ++bj) {
                    const int col = colb + bj * HALF;
                    f32x4 v0 = acc[ai][bj][m][0] * r, v1 = acc[ai][bj][m][1] * r;
                    if (type == 4) {
                        const f32x4 l0 = lbv[bj][0], l1 = lbv[bj][1];
#pragma unroll
                        for (int j = 0; j < 4; ++j) { v0[j] = __logf(l0[j] + (1.f - l0[j]) * fsigmoid(v0[j])); v1[j] = __logf(l1[j] + (1.f - l1[j]) * fsigmoid(v1[j])); }
                        typedef _Float16 h16x8 __attribute__((ext_vector_type(8))); h16x8 hv_;
#pragma unroll
                        for (int j = 0; j < 4; ++j) { hv_[j] = (_Float16)v0[j]; hv_[4 + j] = (_Float16)v1[j]; }
                        *(h16x8*)(logf + (size_t)row * 512 + col) = hv_;
                    } else {
                        if (type == 3 || type == 6) {
#pragma unroll
                            for (int j = 0; j < 4; ++j) { v0[j] = fsilu(v0[j]); v1[j] = fsilu(v1[j]); }
                        } else { v0 = v0 * sc; v1 = v1 * sc; }
                        const u32x4 w8 = pack8(v0, v1);
                        *(u32x4*)(ob + (size_t)row * 512 + col) = w8;
                        if (type == 1) {
                            float a = 0.f;
#pragma unroll
                            for (int e = 0; e < 4; ++e) { const float lo = __uint_as_float(w8[e] << 16), hi = __uint_as_float(w8[e] & 0xffff0000u); a += lo * lo + hi * hi; }
                            a += __shfl_xor(a, 16); a += __shfl_xor(a, 32);
                            kmx[ai][bj] = fmaxf(kmx[ai][bj], a);
                        }
                    }
                }
            }
        if (type == 1) {
#pragma unroll
            for (int ai = 0; ai < 2; ++ai)
#pragma unroll
                for (int bj = 0; bj < 2; ++bj) { float a = kmx[ai][bj];
#pragma unroll
                    for (int o = 1; o < 16; o <<= 1) a = fmaxf(a, __shfl_xor(a, o));
                    if (fr == 0 && fq == 0) { const int tok = u.pm * BM + ai * HALF + wr * 64, bl = tok >> 12, tile = (tok & 4095) >> 6, h = 2 * (u.pn & 1) + bj;
                        __hip_atomic_fetch_max(kmt + ((((bl * 4 + h) * 2 + (wc >> 1)) * 64 + tile) * 2 + (wc & 1)), __float_as_uint(a), __ATOMIC_RELAXED, __HIP_MEMORY_SCOPE_AGENT); } }
        }
    }
};
struct EpiRowFp8 {
    static constexpr bool PERM = true, MIDK = false; static constexpr int MID1 = -1, MID2 = -1;
    unsigned char* O; float cs;
    __device__ __forceinline__ void operator()(const Acc& acc, const Unit& u, int wr, int wc, int fr, int fq) const {
        const int colb = u.pn * BM + wc * 32 + 8 * fq;
#pragma unroll
        for (int ai = 0; ai < 2; ++ai)
#pragma unroll
            for (int m = 0; m < 4; ++m) {
                const int row = u.pm * BM + ai * HALF + wr * 64 + m * 16 + fr;
#pragma unroll
                for (int bj = 0; bj < 2; ++bj) {
                    const f32x4 v0 = acc[ai][bj][m][0] * cs, v1 = acc[ai][bj][m][1] * cs; u32x2 w; w.x = pk4_fp8(v0[0], v0[1], v0[2], v0[3]); w.y = pk4_fp8(v1[0], v1[1], v1[2], v1[3]);
                    *(u32x2*)(O + (size_t)row * 1024 + colb + bj * HALF) = w;
                }
            }
    }
};
template <int ACT> struct EpiRowBf16 {
    static constexpr bool PERM = true, MIDK = false; static constexpr int MID1 = -1, MID2 = -1;
    bf16_t* O; int ldc; const float* rs; float cs;
    __device__ __forceinline__ void operator()(const Acc& acc, const Unit& u, int wr, int wc, int fr, int fq) const {
        const int colb = u.pn * BM + wc * 32 + 8 * fq;
        float rv[2][4];
#pragma unroll
        for (int ai = 0; ai < 2; ++ai)
#pragma unroll
            for (int m = 0; m < 4; ++m) rv[ai][m] = rs ? rs[u.pm * BM + ai * HALF + wr * 64 + m * 16 + fr] : 1.f;
#pragma unroll
        for (int ai = 0; ai < 2; ++ai)
#pragma unroll
            for (int m = 0; m < 4; ++m) {
                const int row = u.pm * BM + ai * HALF + wr * 64 + m * 16 + fr; const float r = rv[ai][m];
#pragma unroll
                for (int bj = 0; bj < 2; ++bj) {
                    f32x4 v0 = acc[ai][bj][m][0] * (r * cs), v1 = acc[ai][bj][m][1] * (r * cs);
                    if (ACT == 1) {
#pragma unroll
                        for (int j = 0; j < 4; ++j) { v0[j] = fsigmoid(v0[j]); v1[j] = fsigmoid(v1[j]); } }
                    *(u32x4*)(O + (size_t)row * ldc + colb + bj * HALF) = pack8(v0, v1);
                }
            }
    }
};
struct EpiGatesNative {
    static constexpr bool PERM = true, MIDK = false; static constexpr int MID1 = -1, MID2 = -1;
    unsigned char* G; const float* rs;
    __device__ __forceinline__ void operator()(const Acc& acc, const Unit& u, int wr, int wc, int fr, int fq) const {
        float rv[2][4];
#pragma unroll
        for (int ai = 0; ai < 2; ++ai)
#pragma unroll
            for (int m = 0; m < 4; ++m) rv[ai][m] = rs[u.pm * BM + ai * HALF + wr * 64 + m * 16 + fr];
        unsigned char* gt = G + (size_t)((u.pm * 12 + u.pn) * 8 + wr * 4 + wc) * 8192 + (fq * 16 + fr) * 16;
#pragma unroll
        for (int ai = 0; ai < 2; ++ai)
#pragma unroll
            for (int m = 0; m < 4; ++m) { u32x4 o;
#pragma unroll
                for (int bj = 0; bj < 2; ++bj)
#pragma unroll
                    for (int n = 0; n < 2; ++n) { const f32x4 v = acc[ai][bj][m][n] * rv[ai][m]; unsigned w = 0;
#pragma unroll
                        for (int j = 0; j < 4; ++j) w = __builtin_amdgcn_cvt_pk_u8_f32(fmaxf(255.f * fsigmoid(v[j]), 1.f), j, w);
                        o[bj * 2 + n] = w; }
                *(u32x4*)(gt + (ai * 4 + m) * 1024) = o; }
    }
};
struct EpiMerge {
    static constexpr bool PERM = true, MIDK = true; static constexpr int MID1 = 8, MID2 = 16;
    const unsigned char* gates; bf16_t* O;
    __device__ __forceinline__ void mid(Acc& acc, const Unit& u, int t, int wr, int wc, int fr, int fq) const {
        const int i = (t == MID1) ? 0 : 1;
        const unsigned char* gp0 = gates + (size_t)((u.pm * 12 + i * 4 + u.pn) * 8 + wr * 4 + wc) * 8192 + (fq * 16 + fr) * 16;
        u32x4 av[8], bv[8];
#pragma unroll
        for (int g = 0; g < 8; ++g) { av[g] = *(const u32x4*)(gp0 + g * 1024); bv[g] = *(const u32x4*)(gp0 + g * 1024 + (size_t)4 * 8 * 8192); }
        __builtin_amdgcn_sched_barrier(0);
#pragma unroll
        for (int ai = 0; ai < 2; ++ai)
#pragma unroll
            for (int m = 0; m < 4; ++m) { const u32x4 a = av[ai * 4 + m], b = bv[ai * 4 + m];
#pragma unroll
                for (int bj = 0; bj < 2; ++bj)
#pragma unroll
                    for (int n = 0; n < 2; ++n)
#pragma unroll
                        for (int e = 0; e < 4; ++e) acc[ai][bj][m][n][e] *= (float)((a[bj * 2 + n] >> (8 * e)) & 255u) * __builtin_amdgcn_rcpf((float)((b[bj * 2 + n] >> (8 * e)) & 255u));
            }
    }
    __device__ __forceinline__ void operator()(const Acc& acc, const Unit& u, int wr, int wc, int fr, int fq) const {
        const int colb = u.pn * BM + wc * 32 + 8 * fq;
#pragma unroll
        for (int ai = 0; ai < 2; ++ai) {
            u32x4 av[4];
#pragma unroll
            for (int m = 0; m < 4; ++m) av[m] = *(const u32x4*)(gates + (size_t)((u.pm * 12 + 8 + u.pn) * 8 + wr * 4 + wc) * 8192 + (ai * 4 + m) * 1024 + (fq * 16 + fr) * 16);
            __builtin_amdgcn_sched_barrier(0);
#pragma unroll
            for (int m = 0; m < 4; ++m) {
                const int row = u.pm * BM + ai * HALF + wr * 64 + m * 16 + fr; const u32x4 a = av[m];
#pragma unroll
                for (int bj = 0; bj < 2; ++bj) {
                    f32x4 v0 = acc[ai][bj][m][0], v1 = acc[ai][bj][m][1];
#pragma unroll
                    for (int e = 0; e < 4; ++e) { v0[e] *= (float)((a[bj * 2] >> (8 * e)) & 255u) * (1.f / 255.f); v1[e] *= (float)((a[bj * 2 + 1] >> (8 * e)) & 255u) * (1.f / 255.f); }
                    *(u32x4*)(O + (size_t)row * 1024 + colb + bj * HALF) = pack8(v0, v1);
                }
            }
        }
    }
};
struct EpiOut {
    static constexpr bool PERM = true, MIDK = false; static constexpr int MID1 = -1, MID2 = -1;
    bf16_t* xb; unsigned char* xb8;
    __device__ __forceinline__ void operator()(const Acc& acc, const Unit& u, int wr, int wc, int fr, int fq) const {
        const int colb = u.pn * BM + wc * 32 + 8 * fq;
#pragma unroll
        for (int ai = 0; ai < 2; ++ai) {
            u32x4 xo[4][2];
#pragma unroll
            for (int m = 0; m < 4; ++m)
#pragma unroll
                for (int bj = 0; bj < 2; ++bj) xo[m][bj] = *(const u32x4*)(xb + (size_t)(u.pm * BM + ai * HALF + wr * 64 + m * 16 + fr) * D + colb + bj * HALF);
            __builtin_amdgcn_sched_barrier(0);
#pragma unroll
            for (int m = 0; m < 4; ++m)
#pragma unroll
                for (int bj = 0; bj < 2; ++bj) {
                    const size_t o = (size_t)(u.pm * BM + ai * HALF + wr * 64 + m * 16 + fr) * D + colb + bj * HALF; const u32x4 b = xo[m][bj];
                    const f32x4 v0 = (f32x4){__uint_as_float(b.x << 16), __uint_as_float(b.x & 0xffff0000u), __uint_as_float(b.y << 16), __uint_as_float(b.y & 0xffff0000u)} + acc[ai][bj][m][0];
                    const f32x4 v1 = (f32x4){__uint_as_float(b.z << 16), __uint_as_float(b.z & 0xffff0000u), __uint_as_float(b.w << 16), __uint_as_float(b.w & 0xffff0000u)} + acc[ai][bj][m][1];
                    *(u32x4*)(xb + o) = pack8(v0, v1);
                    u32x2 w8; w8.x = pk4_fp8(v0[0], v0[1], v0[2], v0[3]); w8.y = pk4_fp8(v1[0], v1[1], v1[2], v1[3]); *(u32x2*)(xb8 + o) = w8;
                }
        }
    }
};

struct EpiGateUp {
    static constexpr bool PERM = true, MIDK = false; static constexpr int MID1 = -1, MID2 = -1;
    unsigned char* act; const float* rowrs; const float* rowwt;
    __device__ __forceinline__ void operator()(const Acc& acc, const Unit& u, int wr, int wc, int fr, int fq) const {
        const int colb = u.pn * 128 + wc * 16 + 4 * fq;
        float rv[2][4], wv[2][4];
#pragma unroll
        for (int ai = 0; ai < 2; ++ai)
#pragma unroll
            for (int m = 0; m < 4; ++m) { const int row = u.pm * BM + ai * HALF + wr * 64 + m * 16 + fr; rv[ai][m] = rowrs[row]; wv[ai][m] = rowwt[row]; }
#pragma unroll
        for (int ai = 0; ai < 2; ++ai)
#pragma unroll
            for (int m = 0; m < 4; ++m) {
                const int row = u.pm * BM + ai * HALF + wr * 64 + m * 16 + fr; const float r = rv[ai][m] * (1.f / W8_SCALE), w = wv[ai][m] * ACT8_SCALE;
#pragma unroll
                for (int bj = 0; bj < 2; ++bj) {
                    const f32x4 gt = acc[ai][bj][m][0] * r, up = acc[ai][bj][m][1] * r; f32x4 a;
#pragma unroll
                    for (int j = 0; j < 4; ++j) a[j] = fsilu(gt[j]) * up[j] * w;
                    *(unsigned*)(act + (size_t)row * DE + colb + bj * 64) = pk4_fp8(a[0], a[1], a[2], a[3]);
                }
            }
    }
};
}

constexpr int LDS_BYTES = 147456;
constexpr int NTHREADS = 512;

__device__ __forceinline__ void setup_phase(const Params& p, int b0, int nb) {
    unsigned char* ws = p.ws; const int tid = threadIdx.x;
    float* lam = (float*)(ws + WS_LAM); float* lbs = (float*)(ws + WS_LBS); float* wrt = (float*)(ws + WS_WRT);
    if (b0 == 0) {
        if (tid < 128) {
            const int l = tid >> 6, lane = tid & 63; const float* lp = p.in[4] + l * 256;
            const float a = wave_sum(lp[lane] * lp[64 + lane]), b = wave_sum(lp[128 + lane] * lp[192 + lane]);
            const float lam_init = 0.8f - 0.6f * expf(-0.3f * (float)l);
            if (lane == 0) lam[l] = expf(a) - expf(b) + lam_init;
        }
        { const int i = tid; const float v0 = p.in[6][i], v1 = p.in[6][512 + i]; const float m = fmaxf(v0, v1); const float e0 = expf(v0 - m), e1 = expf(v1 - m);
            lbs[i] = 0.f; lbs[512 + i] = e1 / (e0 + e1); }
    }
    for (int i = b0 * 512 + tid; i < 2 * 1024 * 16; i += nb * 512) { const int l = i >> 14, ii = i & 3, e = (i >> 2) & 15, qd = (i >> 6) & 3, sidx = (i >> 8) & 63; const int k = 16 * sidx + 4 * qd + ii; wrt[i] = p.in[12][l * 1024 + k] * p.in[13][k * 16 + e]; }
}

__device__ __forceinline__ void convert_tile(const float* src, int ldsrc, const float* gain, bf16_t* dst, int Kdst, int k_off, int mode, int kt, int ntile, LAS float* tile) {
    int tid = threadIdx.x; asm volatile("" : "+v"(tid));
    { const int n = tid & 255, k0 = tid >> 8; float v[32];
      const float* sp = src + (size_t)(kt * 64 + k0) * ldsrc + ntile * 256 + n;
#pragma unroll
      for (int j = 0; j < 32; ++j) v[j] = sp[(size_t)(2 * j) * ldsrc];
      __builtin_amdgcn_sched_barrier(0);
#pragma unroll
      for (int j = 0; j < 32; ++j) { const int k = k0 + 2 * j; const float gk = gain ? gain[kt * 64 + k] : 1.f; tile[k * 257 + n] = v[j] * gk; } }
    __syncthreads();
    { const int c = tid & 7;
#pragma unroll
      for (int i = 0; i < 4; ++i) { const int n = (tid >> 3) + 64 * i; const LAS float* sl = tile + (8 * c) * 257 + n;
          u32x4 o; o.x = pk2(sl[0], sl[257]); o.y = pk2(sl[514], sl[771]); o.z = pk2(sl[1028], sl[1285]); o.w = pk2(sl[1542], sl[1799]);
          const int ng = ntile * 256 + n; const int row = mode == 0 ? ng : (8 * (ng >> 2) + (ng & 3) + (mode == 2 ? 4 : 0));
          *(u32x4*)(dst + (size_t)row * Kdst + k_off + kt * 64 + 8 * c) = o; } }
    __syncthreads();
}
__device__ __forceinline__ void convert_tile8(const float* src, int ldsrc, const float* gain, unsigned char* dst, int Kdst, int mode, int kt, int ntile, LAS float* tile) {
    int tid = threadIdx.x; asm volatile("" : "+v"(tid));
    { const int n = tid & 255, k0 = tid >> 8; float v[32];
      const float* sp = src + (size_t)(kt * 64 + k0) * ldsrc + ntile * 256 + n;
#pragma unroll
      for (int j = 0; j < 32; ++j) v[j] = sp[(size_t)(2 * j) * ldsrc];
      __builtin_amdgcn_sched_barrier(0);
#pragma unroll
      for (int j = 0; j < 32; ++j) { const int k = k0 + 2 * j; const float gk = (gain ? gain[kt * 64 + k] : 1.f) * W8_SCALE; tile[k * 257 + n] = v[j] * gk; } }
    __syncthreads();
    { const int c = tid & 3;
#pragma unroll
      for (int i = 0; i < 2; ++i) { const int n = (tid >> 2) + 128 * i; const LAS float* sl = tile + (16 * c) * 257 + n;
          u32x4 o; o.x = pk4_fp8(sl[0], sl[257], sl[514], sl[771]); o.y = pk4_fp8(sl[1028], sl[1285], sl[1542], sl[1799]); o.z = pk4_fp8(sl[2056], sl[2313], sl[2570], sl[2827]); o.w = pk4_fp8(sl[3084], sl[3341], sl[3598], sl[3855]);
          const int ng = ntile * 256 + n; const int row = mode == 0 ? ng : (8 * (ng >> 2) + (ng & 3) + (mode == 2 ? 4 : 0));
          *(u32x4*)(dst + (size_t)row * Kdst + kt * 64 + 16 * c) = o; } }
    __syncthreads();
}
__device__ __forceinline__ void convert_tile_i8(const float* src, int ldsrc, const float* gain, const unsigned* wmax, float* wsc, unsigned char* dst, int kt, int ntile, LAS float* tile) {
    int tid = threadIdx.x; asm volatile("" : "+v"(tid));
    { const int n = tid & 255, k0 = tid >> 8; float v[32];
      const float* sp = src + (size_t)(kt * 64 + k0) * ldsrc + ntile * 256 + n;
#pragma unroll
      for (int j = 0; j < 32; ++j) v[j] = sp[(size_t)(2 * j) * ldsrc];
      const float am = fmaxf(__uint_as_float(wmax[ntile * 256 + n]), 1e-30f), inv = 127.f / am;
      if (kt == 0 && k0 == 0) wsc[ntile * 256 + n] = am * (1.f / 127.f);
      __builtin_amdgcn_sched_barrier(0);
#pragma unroll
      for (int j = 0; j < 32; ++j) { const int k = k0 + 2 * j; const float gk = gain[kt * 64 + k]; tile[k * 257 + n] = (v[j] * gk) * inv; } }
    __syncthreads();
    { const int c = tid & 3;
#pragma unroll
      for (int i = 0; i < 2; ++i) { const int n = (tid >> 2) + 128 * i; const LAS float* sl = tile + (16 * c) * 257 + n;
          u32x4 o; o.x = pk4_i8(sl[0], sl[257], sl[514], sl[771]); o.y = pk4_i8(sl[1028], sl[1285], sl[1542], sl[1799]); o.z = pk4_i8(sl[2056], sl[2313], sl[2570], sl[2827]); o.w = pk4_i8(sl[3084], sl[3341], sl[3598], sl[3855]);
          *(u32x4*)(dst + (size_t)(ntile * 256 + n) * 1024 + kt * 64 + 16 * c) = o; } }
    __syncthreads();
}
__device__ __forceinline__ void wmax_phase(const Params& p, int b0, int nb) {
    int tid = threadIdx.x; asm volatile("" : "+v"(tid));
    for (int it = b0; it < 224; it += nb) {
        const int l = it / 112, r = it % 112, ntile = r >> 2, kg = r & 3, n = tid & 255, k0 = tid >> 8; float am = 0.f;
#pragma unroll 1
        for (int kk = 0; kk < 4; ++kk) { const int kt = kg * 4 + kk; float v[32];
            const float* sp = p.in[3] + (size_t)l * D * IN_TOTAL + (size_t)(kt * 64 + k0) * IN_TOTAL + ntile * 256 + n; const float* gain = p.in[2] + l * D + kt * 64 + k0;
#pragma unroll
            for (int j = 0; j < 32; ++j) v[j] = sp[(size_t)(2 * j) * IN_TOTAL];
            __builtin_amdgcn_sched_barrier(0);
#pragma unroll
            for (int j = 0; j < 32; ++j) am = fmaxf(am, fabsf(v[j] * gain[2 * j])); }
        atomicMax((unsigned*)(p.ws + WS_WMAX) + l * IN_TOTAL + ntile * 256 + n, __float_as_uint(am));
    }
}
constexpr int CT_IN = 16 * 28, CT_MEM = 64, CT_BR = 96, CT_OUT = 64, CT_G = 512, CT_U = 512, CT_D = 512;
constexpr int CT_LAYER = CT_IN + CT_MEM + CT_BR + CT_OUT + CT_G + CT_U + CT_D;
__device__ __forceinline__ void convert_mem_phase(const Params& p, LAS float* tile, int b0, int nb) {
    unsigned char* ws = p.ws;
    for (int m = b0; m < 2 * CT_MEM; m += nb) { const int l = m / CT_MEM, r = m % CT_MEM;
        convert_tile(p.in[9] + (size_t)l * D * D, D, p.in[8] + l * D, (bf16_t*)(ws + WS_WMIX + (size_t)l * WMIX_LAYER + WMIX_MEM), D, 0, 0, r / 4, r % 4, tile); }
}
__device__ __forceinline__ void convert_phase(const Params& p, LAS float* tile, int i0, int istride, int hi) {
    unsigned char* ws = p.ws;
    for (int idx = i0; idx < hi; idx += istride) {
        const int l = idx / CT_LAYER; int r = idx % CT_LAYER;
        bf16_t* wmix = (bf16_t*)(ws + WS_WMIX + (size_t)l * WMIX_LAYER); unsigned char* wmoe = ws + WS_WMOE + (size_t)l * WMOE_LAYER;
        if (r < CT_IN) { convert_tile_i8(p.in[3] + (size_t)l * D * IN_TOTAL, IN_TOTAL, p.in[2] + l * D, (const unsigned*)(ws + WS_WMAX) + l * IN_TOTAL, (float*)(ws + WS_WSC) + l * IN_TOTAL, (unsigned char*)wmix, r / 28, r % 28, tile); continue; } r -= CT_IN;
        if (r < CT_MEM) continue; r -= CT_MEM;
        if (r < CT_BR) { const int i = r / 32, rr = r % 32; convert_tile(p.in[10] + (size_t)(l * 3 + i) * 512 * D, D, nullptr, (bf16_t*)((unsigned char*)wmix + WMIX_BR), 1536, i * 512, 0, rr / 4, rr % 4, tile); continue; } r -= CT_BR;
        if (r < CT_OUT) { convert_tile(p.in[11] + (size_t)l * D * D, D, nullptr, (bf16_t*)((unsigned char*)wmix + WMIX_OUT), D, 0, 0, r / 4, r % 4, tile); continue; } r -= CT_OUT;
        if (r < CT_G) { const int e = r / 32, rr = r % 32; convert_tile8(p.in[15] + (size_t)(l * NE + e) * D * DE, DE, p.in[12] + l * D, wmoe + (size_t)e * 1024 * 1024, D, 1, rr / 2, rr % 2, tile); continue; } r -= CT_G;
        if (r < CT_U) { const int e = r / 32, rr = r % 32; convert_tile8(p.in[16] + (size_t)(l * NE + e) * D * DE, DE, p.in[12] + l * D, wmoe + (size_t)e * 1024 * 1024, D, 2, rr / 2, rr % 2, tile); continue; } r -= CT_U;
        { const int e = r / 32, rr = r % 32; convert_tile8(p.in[17] + (size_t)(l * NE + e) * DE * D, D, nullptr, wmoe + WMOE_D + (size_t)e * 1024 * 512, DE, 0, rr / 4, rr % 4, tile); }
    }
}

__device__ __forceinline__ void prep_row(const float* xrow, bf16_t* orow, float* rs_out, int lane, unsigned char* qrow = nullptr) {
    const f32x4* xr = (const f32x4*)xrow + lane; f32x4 v[4]; float s = 0.f;
#pragma unroll
    for (int j = 0; j < 4; ++j) { v[j] = xr[64 * j]; s += (v[j].x * v[j].x + v[j].y * v[j].y) + (v[j].z * v[j].z + v[j].w * v[j].w); }
    s = wave_sum(s);
    float rsv = 1.0f / sqrtf(s * (1.f / D) + EPS);
    u32x2* o = (u32x2*)orow + lane;
#pragma unroll
    for (int j = 0; j < 4; ++j) { u32x2 w; w.x = pk2(v[j].x, v[j].y); w.y = pk2(v[j].z, v[j].w); o[64 * j] = w; }
    if (qrow) { float am = 0.f;
#pragma unroll
        for (int j = 0; j < 4; ++j) am = fmaxf(am, fmaxf(fmaxf(fabsf(v[j].x), fabsf(v[j].y)), fmaxf(fabsf(v[j].z), fabsf(v[j].w))));
        am = fmaxf(wave_max(am), 1e-30f); const float inv = 127.f / am; rsv *= am * (1.f / 127.f);
        unsigned* q = (unsigned*)qrow + lane;
#pragma unroll
        for (int j = 0; j < 4; ++j) q[64 * j] = pk4_i8(v[j].x * inv, v[j].y * inv, v[j].z * inv, v[j].w * inv); }
    if (lane == 0) *rs_out = rsv;
}
__device__ __forceinline__ void prep_phase(const Params& p, int gw, int ngw, int lane) {
    unsigned char* ws = p.ws;
    for (int r = gw; r < NTOK + NMEM; r += ngw) {
        if (r < NTOK) prep_row(p.in[0] + (size_t)r * D, (bf16_t*)(ws + WS_XB) + (size_t)r * D, (float*)(ws + WS_RS) + r, lane, ws + WS_XB8 + (size_t)r * D);
        else { const int m = r - NTOK; prep_row(p.in[1] + (size_t)m * D, (bf16_t*)(ws + WS_MEMB) + (size_t)m * D, (float*)(ws + WS_RSMEM) + m, lane); }
    }
}

__device__ __forceinline__ void phase_memkv(const Params& p, LAS unsigned char* lds, int l, int c, int G) {
    unsigned char* ws = p.ws;
    pg8::Gemm g{(const bf16_t*)(ws + WS_MEMB), (const bf16_t*)(ws + WS_WMIX + (size_t)l * WMIX_LAYER + WMIX_MEM), D};
    pg8::StaticOrder S; S.init(NMEM, D, G, c);
    pg8::EpiRowBf16<0> E{(bf16_t*)(ws + WS_MKV) + (size_t)l * NMEM * D, D, (const float*)(ws + WS_RSMEM), 1.f};
    pg8::gemm_phase<pg8::EpiRowBf16<0>, pg8::StaticOrder, true>(lds, g, S, E);
}
__device__ __forceinline__ void phase_mix(const Params& p, LAS unsigned char* lds, int l, int half) {
    unsigned char* ws = p.ws;
    pg8::Gemm g{(const bf16_t*)(ws + WS_XB8) + (size_t)half * HT * (D / 2), (const bf16_t*)(ws + WS_WMIX + (size_t)l * WMIX_LAYER), D / 2, (const float*)(ws + WS_WSC) + l * IN_TOTAL};
    pg8::StaticOrder S; S.init(HT, MIXW, gridDim.x, blockIdx.x);
    pg8::EpiMix E{(bf16_t*)(ws + WS_BIG + BG_PB), (_Float16*)(ws + WS_BIG + BG_LOGF), (const float*)(ws + WS_RS) + half * HT, (const float*)(ws + WS_LBS) + l * 512, 0.125f * LOG2E, 0.08838834764831845f * LOG2E, (unsigned*)(ws + WS_KM2) + (size_t)(l * 2 + half) * 4096};
    pg8::gemm_phase<pg8::EpiMix, pg8::StaticOrder, true, 2>(lds, g, S, E);
}
__device__ __forceinline__ void phase_gates(const Params& p, LAS unsigned char* lds, int l, int half) {
    unsigned char* ws = p.ws;
    pg8::Gemm g{(const bf16_t*)(ws + WS_XB8) + (size_t)half * HT * (D / 2), (const bf16_t*)(ws + WS_WMIX + (size_t)l * WMIX_LAYER) + (size_t)MIXW * (D / 2), D / 2, (const float*)(ws + WS_WSC) + l * IN_TOTAL + MIXW};
    pg8::GatesOfMerge S; S.init(HT, D, gridDim.x, blockIdx.x);
    pg8::EpiGatesNative E{ws + WS_BIG + BG_GATES, (const float*)(ws + WS_RS) + half * HT};
    pg8::gemm_phase<pg8::EpiGatesNative, pg8::GatesOfMerge, true, 2>(lds, g, S, E);
}
__device__ __forceinline__ void phase_merge(const Params& p, LAS unsigned char* lds, int l, int half) {
    unsigned char* ws = p.ws;
    pg8::Gemm g{(const bf16_t*)(ws + WS_BIG + BG_YCAT), (const bf16_t*)(ws + WS_WMIX + (size_t)l * WMIX_LAYER + WMIX_BR), 1536};
    pg8::StaticOrder S; S.init(HT, D, gridDim.x, blockIdx.x);
    pg8::EpiMerge E{ws + WS_BIG + BG_GATES, (bf16_t*)(ws + WS_BIG + BG_MERGED) + (size_t)half * HT * D};
    pg8::gemm_phase<pg8::EpiMerge, pg8::StaticOrder, true>(lds, g, S, E);
}
__device__ __forceinline__ void phase_out(const Params& p, LAS unsigned char* lds, int l) {
    unsigned char* ws = p.ws;
    pg8::Gemm g{(const bf16_t*)(ws + WS_BIG + BG_MERGED), (const bf16_t*)(ws + WS_WMIX + (size_t)l * WMIX_LAYER + WMIX_OUT), D};
    pg8::StaticOrder S; S.init(NTOK, D, gridDim.x, blockIdx.x);
    pg8::EpiOut E{(bf16_t*)(ws + WS_XB), ws + WS_XB8};
    pg8::gemm_phase<pg8::EpiOut, pg8::StaticOrder, true>(lds, g, S, E);
}
__device__ __forceinline__ void phase_gateup(const Params& p, LAS unsigned char* lds, int l) {
    unsigned char* ws = p.ws;
    const int ntiles = *(const int*)(ws + WS_NTILES);
    pg8::Gemm g{(const bf16_t*)(ws + WS_XB8), (const bf16_t*)(ws + WS_WMOE + (size_t)l * WMOE_LAYER), D / 2};
    pg8::MoeOrder<true> S; S.init(ntiles * 256, 1024, gridDim.x, blockIdx.x); S.tile_exp = (const int*)(ws + WS_TILEEXP); S.rowtok = (const int*)(ws + WS_ROWTOK); S.estride = (size_t)1024 * 1024;
    pg8::EpiGateUp E{ws + WS_BIG + BG_ACT, (const float*)(ws + WS_ROWRS), (const float*)(ws + WS_ROWWT)};
    pg8::gemm_phase<pg8::EpiGateUp, pg8::MoeOrder<true>, true, true>(lds, g, S, E);
}
__device__ __forceinline__ void phase_down(const Params& p, LAS unsigned char* lds, int l) {
    unsigned char* ws = p.ws;
    const int ntiles = *(const int*)(ws + WS_NTILES);
    pg8::Gemm g{(const bf16_t*)(ws + WS_BIG + BG_ACT), (const bf16_t*)(ws + WS_WMOE + (size_t)l * WMOE_LAYER + WMOE_D), DE / 2};
    pg8::MoeOrder<false> S; S.init(ntiles * 256, 1024, gridDim.x, blockIdx.x); S.tile_exp = (const int*)(ws + WS_TILEEXP); S.rowtok = nullptr; S.estride = (size_t)1024 * 512;
    pg8::EpiRowFp8 E{ws + WS_BIG + BG_YSLOT, YS8_SCALE / (W8_SCALE * ACT8_SCALE)};
    pg8::gemm_phase<pg8::EpiRowFp8, pg8::MoeOrder<false>, true, true>(lds, g, S, E);
}

typedef short s16x4 __attribute__((ext_vector_type(4)));
constexpr int KSTR = 272, VSTR = 288;
constexpr int ATT_KBUF = 16384, ATT_STAGE = 32768;
template <bool DIFF>
__device__ __forceinline__ void attn_unit(LAS unsigned char* lds, const bf16_t* Q, int q_ld, const bf16_t* K, int k_ld, const bf16_t* V, int v_ld, int nkt, int i0,
                                          float slope2, float lam, float oscale, const float* sub_g, bf16_t* Y, int y_ld, const unsigned* kmaxp) {
    constexpr int KS = DIFF ? 2 : 4;
    int tid = threadIdx.x; asm volatile("" : "+v"(tid));
    const int wid = __builtin_amdgcn_readfirstlane(tid >> 6), lane = tid & 63, fr = lane & 15, quad = lane >> 4;
    const int map = DIFF ? (wid >> 2) : 0, wq = DIFF ? (wid & 3) : wid, kcol0 = DIFF ? map * 64 : 0;
    const int iw = i0 + 32 * wq;
    const int dr = lane >> 4; const unsigned dlog = (unsigned)((lane & 15) ^ ((dr << 2) | (wid & 3)));
#define ATT_DMA(t, b) do { _Pragma("unroll") for (int _i = 0; _i < 2; ++_i) { const size_t r_ = (size_t)((t) * 64 + 4 * (wid + 8 * _i) + dr); \
        __builtin_amdgcn_global_load_lds((const unsigned*)(K + r_ * k_ld + dlog * 8), (LAS unsigned*)(lds + (b) * ATT_STAGE + (wid + 8 * _i) * 1024), 16, 0, 0); \
        __builtin_amdgcn_global_load_lds((const unsigned*)(V + r_ * v_ld + dlog * 8), (LAS unsigned*)(lds + (b) * ATT_STAGE + ATT_KBUF + (wid + 8 * _i) * 1024), 16, 0, 0); } } while (0)
    ATT_DMA(nkt - 1, 0); ATT_DMA(nkt - 2, 1);
    bf16x8 qf[2][KS];
#pragma unroll
    for (int qb = 0; qb < 2; ++qb)
#pragma unroll
        for (int ks = 0; ks < KS; ++ks) qf[qb][ks] = *(const bf16x8*)(Q + (size_t)(32 * wq + 16 * qb + fr) * q_ld + kcol0 + ks * 32 + quad * 8);
    u32x2 kk2 = {0u, 0u}; if (DIFF && lane < nkt) kk2 = *(const u32x2*)(kmaxp + (map * 64 + lane) * 2);
    f32x4 O[8][2];
#pragma unroll
    for (int db = 0; db < 8; ++db) { O[db][0] = (f32x4){0.f, 0.f, 0.f, 0.f}; O[db][1] = (f32x4){0.f, 0.f, 0.f, 0.f}; }
    float mrow[2] = {0.f, 0.f};
    f32x4 Lacc[2] = {(f32x4){0.f, 0.f, 0.f, 0.f}, (f32x4){0.f, 0.f, 0.f, 0.f}};
    bool noshift = false;
    float qmax = 0.f, kpre = 0.f, mmin = -INFINITY; bool wdone = false; int nact = 0;
    LAS int* dflag = (LAS int*)(lds + 4 * ATT_STAGE);
    if (DIFF) {
        float qs = 0.f;
#pragma unroll
        for (int qb = 0; qb < 2; ++qb) { float a = 0.f;
#pragma unroll
            for (int ks = 0; ks < KS; ++ks)
#pragma unroll
                for (int e = 0; e < 8; ++e) { const float v = bf2f((bf16_t)qf[qb][ks][e]); a += v * v; }
            a += __shfl_xor(a, 16); a += __shfl_xor(a, 32); qs = fmaxf(qs, a); }
#pragma unroll
        for (int o = 1; o < 16; o <<= 1) qs = fmaxf(qs, __shfl_xor(qs, o));
        qmax = __builtin_amdgcn_readfirstlane(sqrtf(qs));
        float v = 0.f; if (lane < nkt) v = sqrtf(__uint_as_float(kk2.x) + __uint_as_float(kk2.y)) * 1.0001f;
#pragma unroll
        for (int o = 1; o < 64; o <<= 1) { const float t_ = __shfl_up(v, o); if (lane >= o) v = fmaxf(v, t_); }
        kpre = v;
        if (tid < 16) dflag[tid] = 0;
    }
    const unsigned fk = (unsigned)(((fr & 3) << 2) | ((fr >> 2) & 3));
    unsigned pk[KS];
#pragma unroll
    for (int ks = 0; ks < KS; ++ks) pk[ks] = (unsigned)(fr * 256) + ((((unsigned)(kcol0 / 8 + 4 * ks + quad)) ^ fk) << 4);
    const int vq = fr >> 2, vp = fr & 3; const unsigned fv = (unsigned)((vq << 2) | quad);
    unsigned pv[8];
#pragma unroll
    for (int db = 0; db < 8; ++db) pv[db] = (unsigned)((4 * quad + vq) * 256) + ((((unsigned)(2 * db + (vp >> 1))) ^ fv) << 4) + 8u * (unsigned)(vp & 1);
    __syncthreads();
    int buf = 0;
    for (int tp = nkt / 2 - 1; tp >= 0; --tp) {
        if (tp > 0) { ATT_DMA(2 * tp - 1, (buf ^ 1) * 2); ATT_DMA(2 * tp - 2, (buf ^ 1) * 2 + 1); }
        __builtin_amdgcn_sched_barrier(0);
#pragma unroll 1
      for (int s2 = 0; s2 < 2; ++s2) {
        const int t = 2 * tp + 1 - s2;
        const int j0 = t * 64;
        if (DIFF && !wdone && nact >= 2) {
            const float dmin = (float)(iw - (j0 + 63));
            if (dmin > 0.f && qmax * __shfl(kpre, t) - slope2 * dmin < mmin - 40.f) wdone = true;
        }
        const bool active = !DIFF || ((j0 <= iw + 31) && !wdone);
        if (DIFF && lane == 0 && s2 == 1) dflag[(tp & 1) * 8 + wid] = wdone ? 1 : 0;
        if (active) {
            const LAS unsigned char* kb_ = lds + (buf * 2 + s2) * ATT_STAGE; const LAS unsigned char* vb_ = kb_ + ATT_KBUF;
            float ib[2];
#pragma unroll
            for (int qb = 0; qb < 2; ++qb) ib[qb] = (DIFF ? slope2 * (float)(j0 + quad * 4 - (iw + 16 * qb + fr)) : 0.f) - mrow[qb];
            f32x4 sacc[4][2];
#pragma unroll
            for (int kb = 0; kb < 4; ++kb) { sacc[kb][0] = (f32x4){ib[0], ib[0], ib[0], ib[0]}; sacc[kb][1] = (f32x4){ib[1], ib[1], ib[1], ib[1]}; }
#pragma unroll
            for (int kb = 0; kb < 4; ++kb)
#pragma unroll
                for (int ks = 0; ks < KS; ++ks) { const bf16x8 kf = *(const LAS bf16x8*)(kb_ + kb * 4096 + pk[ks]);
                    sacc[kb][0] = __builtin_amdgcn_mfma_f32_16x16x32_bf16(kf, qf[0][ks], sacc[kb][0], 0, 0, 0); sacc[kb][1] = __builtin_amdgcn_mfma_f32_16x16x32_bf16(kf, qf[1][ks], sacc[kb][1], 0, 0, 0); }
            bf16x8 pf[2][2];
#pragma unroll
            for (int qb = 0; qb < 2; ++qb) {
                if (DIFF) {
#pragma unroll
                    for (int kb = 0; kb < 4; ++kb)
#pragma unroll
                        for (int jj = 0; jj < 4; ++jj) sacc[kb][qb][jj] = fmaf(slope2, (float)(16 * kb + jj), sacc[kb][qb][jj]);
                    if (j0 + 63 > iw + 16 * qb) { const int iq = iw + 16 * qb + fr;
#pragma unroll
                        for (int kb = 0; kb < 4; ++kb)
#pragma unroll
                            for (int jj = 0; jj < 4; ++jj) if (j0 + 16 * kb + quad * 4 + jj > iq) sacc[kb][qb][jj] = -INFINITY; }
                }
                if (!noshift) {
                    float mx = fmaxf(fmaxf(sacc[0][qb][0], sacc[0][qb][1]), fmaxf(sacc[0][qb][2], sacc[0][qb][3]));
#pragma unroll
                    for (int kb = 1; kb < 4; ++kb) mx = fmaxf(mx, fmaxf(fmaxf(sacc[kb][qb][0], sacc[kb][qb][1]), fmaxf(sacc[kb][qb][2], sacc[kb][qb][3])));
                    if (nact == 0 || __any(mx > 8.f)) {
                        mx = fmaxf(mx, __shfl_xor(mx, 16)); mx = fmaxf(mx, __shfl_xor(mx, 32));
                        const float delta = (nact == 0) ? mx : fmaxf(mx, 0.f); const float alpha = __builtin_amdgcn_exp2f(-delta);
                        mrow[qb] += delta; Lacc[qb] = Lacc[qb] * alpha;
#pragma unroll
                        for (int db = 0; db < 8; ++db) O[db][qb] = O[db][qb] * alpha;
#pragma unroll
                        for (int kb = 0; kb < 4; ++kb) sacc[kb][qb] = sacc[kb][qb] - delta;
                    }
                }
#pragma unroll
                for (int kb = 0; kb < 4; ++kb)
#pragma unroll
                    for (int jj = 0; jj < 4; ++jj) sacc[kb][qb][jj] = __builtin_amdgcn_exp2f(sacc[kb][qb][jj]);
#pragma unroll
                for (int kk = 0; kk < 2; ++kk) { u32x4 w; w.x = cvt_pk_bf16(sacc[2 * kk][qb][0], sacc[2 * kk][qb][1]); w.y = cvt_pk_bf16(sacc[2 * kk][qb][2], sacc[2 * kk][qb][3]);
                    w.z = cvt_pk_bf16(sacc[2 * kk + 1][qb][0], sacc[2 * kk + 1][qb][1]); w.w = cvt_pk_bf16(sacc[2 * kk + 1][qb][2], sacc[2 * kk + 1][qb][3]); pf[qb][kk] = __builtin_bit_cast(bf16x8, w); }
            }
            { const u32x4 o1 = (u32x4){0x3f803f80u, 0x3f803f80u, 0x3f803f80u, 0x3f803f80u}; const bf16x8 ones = __builtin_bit_cast(bf16x8, o1);
#pragma unroll
              for (int kk = 0; kk < 2; ++kk) { Lacc[0] = __builtin_amdgcn_mfma_f32_16x16x32_bf16(ones, pf[0][kk], Lacc[0], 0, 0, 0); Lacc[1] = __builtin_amdgcn_mfma_f32_16x16x32_bf16(ones, pf[1][kk], Lacc[1], 0, 0, 0); } }
#pragma unroll
            for (int db = 0; db < 8; ++db)
#pragma unroll
                for (int kk = 0; kk < 2; ++kk) {
                    const LAS unsigned char* va_ = vb_ + kk * 8192 + pv[db];
                    const s16x4 v0 = __builtin_amdgcn_ds_read_tr16_b64_v4i16((LAS s16x4*)va_), v1 = __builtin_amdgcn_ds_read_tr16_b64_v4i16((LAS s16x4*)(va_ + 4096));
                    bf16x8 vf; vf[0] = v0[0]; vf[1] = v0[1]; vf[2] = v0[2]; vf[3] = v0[3]; vf[4] = v1[0]; vf[5] = v1[1]; vf[6] = v1[2]; vf[7] = v1[3];
                    O[db][0] = __builtin_amdgcn_mfma_f32_16x16x32_bf16(vf, pf[0][kk], O[db][0], 0, 0, 0); O[db][1] = __builtin_amdgcn_mfma_f32_16x16x32_bf16(vf, pf[1][kk], O[db][1], 0, 0, 0);
                }
            if (DIFF && nact == 0) noshift = (qmax * __shfl(kpre, nkt - 1) < 50.f);
            if (DIFF && nact < 2) { float mm = fminf(mrow[0], mrow[1]);
#pragma unroll
                for (int o = 1; o < 16; o <<= 1) mm = fminf(mm, __shfl_xor(mm, o));
                mmin = __builtin_amdgcn_readfirstlane(mm); }
            ++nact;
        }
      }
        __syncthreads();
        buf ^= 1;
        if (DIFF) { const LAS int* f_ = dflag + (tp & 1) * 8; const u32x4 fa = *(const LAS u32x4*)f_, fb = *(const LAS u32x4*)(f_ + 4);
            if ((fa.x & fa.y & fa.z & fa.w & fb.x & fb.y & fb.z & fb.w) != 0u) break; }
    }
    if (DIFF) __syncthreads();
#undef ATT_DMA
    float inv[2];
#pragma unroll
    for (int qb = 0; qb < 2; ++qb) inv[qb] = 1.0f / Lacc[qb][0];
    if (DIFF) {
        LAS float* xch = (LAS float*)lds;
        if (map == 1) {
#pragma unroll
            for (int db = 0; db < 8; ++db)
#pragma unroll
                for (int qb = 0; qb < 2; ++qb)
#pragma unroll
                    for (int jj = 0; jj < 4; ++jj) xch[(wq * 64 + (db * 2 + qb) * 4 + jj) * 64 + lane] = O[db][qb][jj] * inv[qb] * lam;
        }
        __syncthreads();
        if (map == 0) {
            f32x4 gv[8];
#pragma unroll
            for (int db = 0; db < 8; ++db) gv[db] = *(const f32x4*)(sub_g + 16 * db + quad * 4);
#pragma unroll
            for (int qb = 0; qb < 2; ++qb) {
                float ss = 0.f;
#pragma unroll
                for (int db = 0; db < 8; ++db)
#pragma unroll
                    for (int jj = 0; jj < 4; ++jj) { const float o = O[db][qb][jj] * inv[qb] - xch[(wq * 64 + (db * 2 + qb) * 4 + jj) * 64 + lane]; O[db][qb][jj] = o; ss += o * o; }
                ss += __shfl_xor(ss, 16); ss += __shfl_xor(ss, 32);
                const float r = oscale / sqrtf(ss * (1.f / 128.f) + EPS);
                bf16_t* yr = Y + (size_t)(32 * wq + 16 * qb + fr) * y_ld + quad * 4;
#pragma unroll
                for (int db = 0; db < 8; ++db) { const f32x4 g = gv[db]; u32x2 w; w.x = cvt_pk_bf16(O[db][qb][0] * r * g[0], O[db][qb][1] * r * g[1]); w.y = cvt_pk_bf16(O[db][qb][2] * r * g[2], O[db][qb][3] * r * g[3]);
                    *(u32x2*)(yr + 16 * db) = w; }
            }
        }
        __syncthreads();
    } else {
#pragma unroll
        for (int qb = 0; qb < 2; ++qb) { bf16_t* yr = Y + (size_t)(32 * wq + 16 * qb + fr) * y_ld + quad * 4;
#pragma unroll
            for (int db = 0; db < 8; ++db) { u32x2 w; w.x = cvt_pk_bf16(O[db][qb][0] * inv[qb], O[db][qb][1] * inv[qb]); w.y = cvt_pk_bf16(O[db][qb][2] * inv[qb], O[db][qb][3] * inv[qb]); *(u32x2*)(yr + 16 * db) = w; } }
    }
}
constexpr size_t WS_QCTR = 8192;

constexpr size_t WS_BTOT = 3 * MiB + 786432;
constexpr int HL_QH = 0, HL_KH = 17408, HL_Q1 = 34816, HL_K2 = 52224, HL_VT = 70656, HL_AT = 89088, HL_SEG = 98304, HL_D = 102400, HL_ER = 136704, HL_ETR = 137216;
constexpr int ATSTR = 144;
struct HgIn { unsigned lfh[8]; unsigned q[8]; u32x4 v[2]; };
template <bool FULL>
__device__ __forceinline__ void hg_load(HgIn& in, const _Float16* lf, const bf16_t* hq, const bf16_t* hv) {
    int tid = threadIdx.x; asm volatile("" : "+v"(tid)); const int kp = tid & 63, tq = tid >> 6;
#pragma unroll
    for (int i = 0; i < 8; ++i) { in.lfh[i] = *(const unsigned*)(lf + (size_t)(8 * tq + i) * 512 + 2 * kp); if (FULL) in.q[i] = *(const unsigned*)(hq + (size_t)(8 * tq + i) * 512 + 2 * kp); }
    const int srow = tid >> 4, sc = tid & 15;
#pragma unroll
    for (int i = 0; i < 2; ++i) in.v[i] = *(const u32x4*)(hv + (size_t)(srow + 32 * i) * 512 + sc * 8);
    __builtin_amdgcn_sched_barrier(0);
}
template <bool FULL>
__device__ __forceinline__ f32x2 hg_build(LAS unsigned char* lds, const HgIn& in, f32x2 Radd) {
    int tid = threadIdx.x; asm volatile("" : "+v"(tid)); const int kp = tid & 63, tq = tid >> 6;
    f32x2 cum[8]; f32x2 c = (f32x2){0.f, 0.f};
    typedef _Float16 h16x2 __attribute__((ext_vector_type(2))); f32x2 lfv[8];
#pragma unroll
    for (int i = 0; i < 8; ++i) { const h16x2 h_ = __builtin_bit_cast(h16x2, in.lfh[i]); lfv[i] = (f32x2){(float)h_[0], (float)h_[1]}; c = c + lfv[i]; cum[i] = c; }
    LAS float* seg = (LAS float*)(lds + HL_SEG);
    *(LAS f32x2*)(seg + tq * 128 + 2 * kp) = c;
    { const int srow = tid >> 4, sc = tid & 15;
#pragma unroll
      for (int i = 0; i < 2; ++i) *(LAS u32x4*)(lds + HL_VT + (srow + 32 * i) * VSTR + sc * 16) = in.v[i]; }
    lds_barrier();
    f32x2 pre = (f32x2){0.f, 0.f}, tot = (f32x2){0.f, 0.f}, r = (f32x2){0.f, 0.f};
#pragma unroll
    for (int q = 0; q < 8; ++q) { const f32x2 v = *(const LAS f32x2*)(seg + q * 128 + 2 * kp); tot = tot + v; if (q < 4) r = r + v; if (q < tq) pre = pre + v; }
    const f32x2 er = (f32x2){__expf(r.x), __expf(r.y)}, etr = (f32x2){__expf(tot.x - r.x + Radd.x), __expf(tot.y - r.y + Radd.y)};
#pragma unroll
    for (int i = 0; i < 8; ++i) {
        const int t = 8 * tq + i; const f32x2 b = pre + cum[i];
        const float kk0 = 1.f - __expf(lfv[i].x), kk1 = 1.f - __expf(lfv[i].y);
        const float e10 = __expf(fminf(fmaxf(b.x - r.x, -80.f), 80.f)), e11 = __expf(fminf(fmaxf(b.y - r.y, -80.f), 80.f));
        const float i10 = __builtin_amdgcn_rcpf(e10), i11 = __builtin_amdgcn_rcpf(e11);
        const float kh0 = kk0 * i10, kh1 = kk1 * i11;
        if (FULL) {
            const float q0 = __uint_as_float(in.q[i] << 16), q1 = __uint_as_float(in.q[i] & 0xffff0000u);
            *(LAS unsigned*)(lds + HL_QH + t * KSTR + kp * 4) = cvt_pk_bf16(q0 * e10, q1 * e11);
            *(LAS unsigned*)(lds + HL_KH + t * KSTR + kp * 4) = cvt_pk_bf16(kh0, kh1);
        } else {
            *(LAS unsigned*)(lds + HL_K2 + t * VSTR + kp * 4) = cvt_pk_bf16(kh0 * etr.x, kh1 * etr.y);
        }
    }
    if (FULL && tq == 1) { *(LAS f32x2*)(lds + HL_ER + kp * 8) = er; *(LAS f32x2*)(lds + HL_ETR + kp * 8) = etr; }
    if (FULL && tq == 0) *(LAS f32x2*)(lds + HL_D + kp * 8) = (f32x2){__expf(tot.x), __expf(tot.y)};
    return tot;
}
__device__ __forceinline__ bf16x8 tr_frag(const LAS unsigned char* base, int stride, int kk, int cb, int lane) {
    const int fr = lane & 15, quad = lane >> 4; const LAS unsigned char* a = base + (32 * kk + 8 * quad + (fr >> 2)) * stride + 32 * cb + 8 * (fr & 3);
    const s16x4 v0 = __builtin_amdgcn_ds_read_tr16_b64_v4i16((LAS s16x4*)a), v1 = __builtin_amdgcn_ds_read_tr16_b64_v4i16((LAS s16x4*)(a + 4 * stride));
    bf16x8 f; f[0] = v0[0]; f[1] = v0[1]; f[2] = v0[2]; f[3] = v0[3]; f[4] = v1[0]; f[5] = v1[1]; f[6] = v1[2]; f[7] = v1[3]; return f;
}
__device__ __forceinline__ void phase_hgrnA(const Params& p, LAS unsigned char* lds, int b0, int nb) {
    unsigned char* ws = p.ws; int tid = threadIdx.x; asm volatile("" : "+v"(tid)); const int wid = __builtin_amdgcn_readfirstlane(tid >> 6), lane = tid & 63;
    const bf16_t* hv = (const bf16_t*)(ws + WS_BIG + BG_PB) + (size_t)SL_HV * HT * 512; const _Float16* lf = (const _Float16*)(ws + WS_BIG + BG_LOGF);
    for (int u = b0; u < 256; u += nb) {
        const int j = u & 15, h = (u >> 4) & 3, bl = u >> 6; const size_t tok0 = (size_t)bl * SEQ + j * 256;
        f32x4 acc[8];
#pragma unroll
        for (int kb = 0; kb < 8; ++kb) acc[kb] = (f32x4){0.f, 0.f, 0.f, 0.f};
        f32x2 R = (f32x2){0.f, 0.f};
        HgIn cur; { const size_t tb = (tok0 + 64 * 3) * 512 + h * 128; hg_load<false>(cur, lf + tb, nullptr, hv + tb); }
#pragma unroll 1
        for (int c = 3; c >= 0; --c) {
            R = R + hg_build<false>(lds, cur, R);
            lds_barrier();
            if (c > 0) { const size_t tb = (tok0 + 64 * (c - 1)) * 512 + h * 128; hg_load<false>(cur, lf + tb, nullptr, hv + tb); }
            bf16x8 vf[2]; vf[0] = tr_frag(lds + HL_VT, VSTR, 0, wid, lane); vf[1] = tr_frag(lds + HL_VT, VSTR, 1, wid, lane);
#pragma unroll
            for (int kb = 0; kb < 8; ++kb)
#pragma unroll
                for (int kk = 0; kk < 2; ++kk) acc[kb] = __builtin_amdgcn_mfma_f32_16x16x32_bf16(tr_frag(lds + HL_K2, VSTR, kk, kb, lane), vf[kk], acc[kb], 0, 0, 0);
            lds_barrier();
        }
        float* Ln = (float*)(ws + WS_ST) + (size_t)u * 16384 + wid * 2048;
#pragma unroll
        for (int kb = 0; kb < 8; ++kb) *(f32x4*)(Ln + (kb * 64 + lane) * 4) = acc[kb];
        if (tid < 64) *(f32x2*)((float*)(ws + WS_BTOT) + u * 128 + 2 * tid) = (f32x2){__expf(R.x), __expf(R.y)};
    }
}
constexpr int HL_DTAB = 138240;
constexpr int HL_OB = 102912, OBSTR = 132;
__device__ __forceinline__ void hgrnC_unit(const Params& p, LAS unsigned char* lds, int l, int u) {
    unsigned char* ws = p.ws; int tid = threadIdx.x; asm volatile("" : "+v"(tid)); const int wid = __builtin_amdgcn_readfirstlane(tid >> 6), lane = tid & 63, fr = lane & 15, quad = lane >> 4;
    const bf16_t* hq = (const bf16_t*)(ws + WS_BIG + BG_PB) + (size_t)SL_HQ * HT * 512; const bf16_t* hv = (const bf16_t*)(ws + WS_BIG + BG_PB) + (size_t)SL_HV * HT * 512;
    const bf16_t* hgp = (const bf16_t*)(ws + WS_BIG + BG_PB) + (size_t)SL_HG * HT * 512; bf16_t* ycat = (bf16_t*)(ws + WS_BIG + BG_YCAT);
    const _Float16* lf = (const _Float16*)(ws + WS_BIG + BG_LOGF);
    const int j = u & 15, h = (u >> 4) & 3, bl = u >> 6; const size_t tok0 = (size_t)bl * SEQ + j * 256;
    HgIn cur; { const size_t tb = tok0 * 512 + h * 128; hg_load<true>(cur, lf + tb, hq + tb, hv + tb); }
    f32x4 acc[8];
#pragma unroll
    for (int kb = 0; kb < 8; ++kb) acc[kb] = (f32x4){0.f, 0.f, 0.f, 0.f};
    if (j > 0) {
        const float* Lb = (const float*)(ws + WS_ST) + (size_t)(u - j) * 16384 + wid * 2048 + lane * 4; const int jm = j - 1;
        f32x4 l0[8], l1[8], l2[8];
#define HG_LD(dst, jp_) do { const float* Ln_ = Lb + (size_t)((jp_) < jm ? (jp_) : jm) * 16384; _Pragma("unroll") for (int kb = 0; kb < 8; ++kb) dst[kb] = *(const f32x4*)(Ln_ + kb * 256); } while (0)
#define HG_FOLD(src, jp_) do { _Pragma("unroll") for (int kb = 0; kb < 8; ++kb) acc[kb] = acc[kb] * *(const LAS f32x4*)(lds + HL_DTAB + ((jp_) * 128 + 16 * kb + quad * 4) * 4) + src[kb]; } while (0)
        HG_LD(l0, 0); HG_LD(l1, 1); HG_LD(l2, 2);
        { const float* Dt = (const float*)(ws + WS_BTOT) + (u - j) * 128; for (int i = tid; i < j * 128; i += NTHREADS) ((LAS float*)(lds + HL_DTAB))[i] = Dt[i]; }
        __syncthreads();
#pragma unroll 1
        for (int jp = 0; jp < j; jp += 3) {
            HG_FOLD(l0, jp); HG_LD(l0, jp + 3);
            if (jp + 1 < j) { HG_FOLD(l1, jp + 1); HG_LD(l1, jp + 4); }
            if (jp + 2 < j) { HG_FOLD(l2, jp + 2); HG_LD(l2, jp + 5); }
        }
#undef HG_LD
#undef HG_FOLD
    }
    const float g0 = p.in[7][l * 128 + lane], g1 = p.in[7][l * 128 + 64 + lane];
#pragma unroll 1
    for (int c = 0; c < 4; ++c) {
        (void)hg_build<true>(lds, cur, (f32x2){0.f, 0.f});
        lds_barrier();
        { const int tbk = wid >> 1;
#pragma unroll
          for (int e = 0; e < 2; ++e) { const int sbk = 2 * (wid & 1) + e; f32x4 sa = (f32x4){0.f, 0.f, 0.f, 0.f};
              if (sbk <= tbk) {
#pragma unroll
                  for (int ks = 0; ks < 4; ++ks) { const bf16x8 a = *(const LAS bf16x8*)(lds + HL_QH + (16 * tbk + fr) * KSTR + (ks * 32 + quad * 8) * 2), b = *(const LAS bf16x8*)(lds + HL_KH + (16 * sbk + fr) * KSTR + (ks * 32 + quad * 8) * 2);
                      sa = __builtin_amdgcn_mfma_f32_16x16x32_bf16(a, b, sa, 0, 0, 0); } }
#pragma unroll
              for (int jj = 0; jj < 4; ++jj) { const int t = 16 * tbk + quad * 4 + jj, sidx = 16 * sbk + fr; const float v = (sidx <= t) ? sa[jj] : 0.f; *(LAS bf16_t*)(lds + HL_AT + t * ATSTR + sidx * 2) = (bf16_t)f2bf(v); } } }
        bf16_t ha[8], hb[8];
#pragma unroll
        for (int i = 0; i < 8; ++i) { const bf16_t* hg = hgp + (tok0 + 64 * c + wid * 8 + i) * 512 + h * 128; ha[i] = hg[lane]; hb[i] = hg[64 + lane]; }
        __builtin_amdgcn_sched_barrier(0);
        if (c < 3) { const size_t tb = (tok0 + 64 * (c + 1)) * 512 + h * 128; hg_load<true>(cur, lf + tb, hq + tb, hv + tb); }
        lds_barrier();
        bf16x8 vf[2]; vf[0] = tr_frag(lds + HL_VT, VSTR, 0, wid, lane); vf[1] = tr_frag(lds + HL_VT, VSTR, 1, wid, lane);
        bf16x8 sf[4];
#pragma unroll
        for (int kk = 0; kk < 4; ++kk) { const f32x4 e0 = *(const LAS f32x4*)(lds + HL_ER + (32 * kk + quad * 4) * 4), e1 = *(const LAS f32x4*)(lds + HL_ER + (32 * kk + 16 + quad * 4) * 4); const f32x4 a0 = acc[2 * kk] * e0, a1 = acc[2 * kk + 1] * e1;
            u32x4 w; w.x = cvt_pk_bf16(a0[0], a0[1]); w.y = cvt_pk_bf16(a0[2], a0[3]); w.z = cvt_pk_bf16(a1[0], a1[1]); w.w = cvt_pk_bf16(a1[2], a1[3]); sf[kk] = __builtin_bit_cast(bf16x8, w); }
#pragma unroll
        for (int tbk = 0; tbk < 4; ++tbk) {
            f32x4 o = (f32x4){0.f, 0.f, 0.f, 0.f};
#pragma unroll
            for (int ks = 0; ks < 2; ++ks) { const bf16x8 a = *(const LAS bf16x8*)(lds + HL_AT + (16 * tbk + fr) * ATSTR + (ks * 32 + quad * 8) * 2); o = __builtin_amdgcn_mfma_f32_16x16x32_bf16(a, vf[ks], o, 0, 0, 0); }
#pragma unroll
            for (int kk = 0; kk < 4; ++kk) { const LAS unsigned char* qp = lds + HL_QH + (16 * tbk + fr) * KSTR + (32 * kk + quad * 4) * 2; const u32x2 a0 = *(const LAS u32x2*)qp, a1 = *(const LAS u32x2*)(qp + 32);
                u32x4 aw; aw.x = a0.x; aw.y = a0.y; aw.z = a1.x; aw.w = a1.y; o = __builtin_amdgcn_mfma_f32_16x16x32_bf16(__builtin_bit_cast(bf16x8, aw), sf[kk], o, 0, 0, 0); }
#pragma unroll
            for (int jj = 0; jj < 4; ++jj) ((LAS float*)(lds + HL_OB))[(16 * tbk + quad * 4 + jj) * OBSTR + 16 * wid + fr] = o[jj];
        }
#pragma unroll
        for (int kb = 0; kb < 8; ++kb) { const f32x4 dv = *(const LAS f32x4*)(lds + HL_D + (16 * kb + quad * 4) * 4), ev = *(const LAS f32x4*)(lds + HL_ETR + (16 * kb + quad * 4) * 4);
            f32x4 tmp = (f32x4){0.f, 0.f, 0.f, 0.f};
#pragma unroll
            for (int kk = 0; kk < 2; ++kk) tmp = __builtin_amdgcn_mfma_f32_16x16x32_bf16(tr_frag(lds + HL_KH, KSTR, kk, kb, lane), vf[kk], tmp, 0, 0, 0);
            acc[kb] = acc[kb] * dv + tmp * ev; }
        lds_barrier();
        { float o0[8], o1[8], ss[8];
#pragma unroll
          for (int i = 0; i < 8; ++i) { const LAS float* orow = (const LAS float*)(lds + HL_OB) + (wid * 8 + i) * OBSTR; o0[i] = orow[lane]; o1[i] = orow[64 + lane]; ss[i] = o0[i] * o0[i] + o1[i] * o1[i]; }
#pragma unroll
          for (int o = 1; o < 64; o <<= 1)
#pragma unroll
              for (int i = 0; i < 8; ++i) ss[i] += __shfl_xor(ss[i], o);
#pragma unroll
          for (int i = 0; i < 8; ++i) { const float rr = 1.0f / sqrtf(ss[i] * (1.f / 128.f) + EPS); bf16_t* y = ycat + (tok0 + 64 * c + wid * 8 + i) * 1536 + 512 + h * 128;
              y[lane] = (bf16_t)f2bf(o0[i] * rr * g0 * bf2f(ha[i])); y[64 + lane] = (bf16_t)f2bf(o1[i] * rr * g1 * bf2f(hb[i])); } }
    }
    __syncthreads();
}
__device__ __forceinline__ void phase_diff(const Params& p, LAS unsigned char* lds, int l, int half) {
    unsigned char* ws = p.ws;
    const bf16_t* qa = (const bf16_t*)(ws + WS_BIG + BG_PB) + (size_t)SL_QA * HT * 512; const bf16_t* ka = (const bf16_t*)(ws + WS_BIG + BG_PB) + (size_t)SL_KA * HT * 512;
    const bf16_t* va = (const bf16_t*)(ws + WS_BIG + BG_PB) + (size_t)SL_VA * HT * 512; bf16_t* ycat = (bf16_t*)(ws + WS_BIG + BG_YCAT);
    const float lam = ((const float*)(ws + WS_LAM))[l]; const float lam_init = 0.8f - 0.6f * __expf(-0.3f * (float)l);
    unsigned* qctr = (unsigned*)(ws + WS_QCTR) + 64 * (l * 2 + half); LAS unsigned* uslot = (LAS unsigned*)(lds + LDS_BYTES - 32);
#pragma unroll 1
    for (;;) {
        if (threadIdx.x == 0) *uslot = __hip_atomic_fetch_add(qctr, 1u, __ATOMIC_RELAXED, __HIP_MEMORY_SCOPE_AGENT);
        __syncthreads();
        int idx = (int)*uslot;
        if (idx >= 1024) break;
        if (idx >= 768) {
            const int u = idx - 768, qt = u & 15, hh = (u >> 4) & 3, bl = u >> 6; const int b = half * HB + bl;
            const bf16_t* cq = (const bf16_t*)(ws + WS_BIG + BG_PB) + (size_t)SL_CQ * HT * 512;
            const bf16_t* mkv = (const bf16_t*)(ws + WS_MKV) + (size_t)l * NMEM * D + (size_t)b * MEMLEN * D + hh * 128; const size_t t0 = (size_t)bl * SEQ + qt * 256;
            attn_unit<false>(lds, cq + t0 * 512 + hh * 128, 512, mkv, D, mkv + 512, D, MEMLEN / 64, 0, 0.f, 0.f, 0.f, nullptr, ycat + t0 * 1536 + 1024 + hh * 128, 1536, nullptr);
            continue;
        }
        if (idx >= 256 && idx < 512) { hgrnC_unit(p, lds, l, idx - 256); continue; }
        if (idx >= 512) idx -= 256;
        const int h = 3 - (idx >> 7), rem = idx & 127, qt = 31 - (rem >> 2), bl = rem & 3; const float slope2 = exp2f(-2.0f * (float)(h + 1)) * LOG2E;
        const size_t tb = (size_t)bl * SEQ; const int i0 = qt * 128;
        attn_unit<true>(lds, qa + (tb + i0) * 512 + h * 128, 512, ka + tb * 512 + h * 128, 512, va + tb * 512 + h * 128, 512, 2 * (qt + 1), i0, slope2, lam, 1.f - lam_init, p.in[5] + l * 128,
                        ycat + (tb + i0) * 1536 + h * 128, 1536, (const unsigned*)(ws + WS_KM2) + (size_t)(l * 2 + half) * 4096 + (bl * 4 + h) * 256);
    }
}

__device__ __forceinline__ void route_phase(const Params& p, int l, LAS unsigned char* lds, int b0, int nb) {
    unsigned char* ws = p.ws; int tid = threadIdx.x; asm volatile("" : "+v"(tid)); const int lane = tid & 63, wv = tid >> 6, fr = lane & 15, quad = lane >> 4;
    const float* bias = p.in[14];
    LAS float* wtab = (LAS float*)lds; LAS int* hist = (LAS int*)(lds + 65536);
    { const f32x4* src = (const f32x4*)((const float*)(ws + WS_WRT) + l * 16384);
      f32x4 tv[8];
#pragma unroll
      for (int i = 0; i < 8; ++i) tv[i] = src[tid + 512 * i];
      __builtin_amdgcn_sched_barrier(0);
#pragma unroll
      for (int i = 0; i < 8; ++i) ((LAS f32x4*)wtab)[tid + 512 * i] = tv[i]; }
    const f32x4 bv = *(const f32x4*)(bias + quad * 4);
    __syncthreads();
    for (int ch = b0; ch < NTOK / 128; ch += nb) {
        if (tid < 16) hist[tid] = 0;
        __syncthreads();
        const int tok = ch * 128 + wv * 16 + fr; const u32x2* xr = (const u32x2*)((const bf16_t*)(ws + WS_XB) + (size_t)tok * D) + quad;
        f32x4 acc = (f32x4){0.f, 0.f, 0.f, 0.f}; float ss = 0.f;
        u32x2 xall[64];
#pragma unroll
        for (int sidx = 0; sidx < 64; ++sidx) xall[sidx] = xr[4 * sidx];
        __builtin_amdgcn_sched_barrier(0);
#pragma unroll
        for (int sidx = 0; sidx < 64; ++sidx) {
            const u32x2 xb2 = xall[sidx]; const f32x4 xv = (f32x4){__uint_as_float(xb2.x << 16), __uint_as_float(xb2.x & 0xffff0000u), __uint_as_float(xb2.y << 16), __uint_as_float(xb2.y & 0xffff0000u)}; const f32x4 wv4 = *(const LAS f32x4*)(wtab + ((sidx * 4 + quad) * 16 + fr) * 4);
            ss += (xv.x * xv.x + xv.y * xv.y) + (xv.z * xv.z + xv.w * xv.w);
            acc = __builtin_amdgcn_mfma_f32_16x16x4f32(wv4.x, xv.x, acc, 0, 0, 0); acc = __builtin_amdgcn_mfma_f32_16x16x4f32(wv4.y, xv.y, acc, 0, 0, 0);
            acc = __builtin_amdgcn_mfma_f32_16x16x4f32(wv4.z, xv.z, acc, 0, 0, 0); acc = __builtin_amdgcn_mfma_f32_16x16x4f32(wv4.w, xv.w, acc, 0, 0, 0);
        }
        ss += __shfl_xor(ss, 16); ss += __shfl_xor(ss, 32);
        const float r = 1.0f / sqrtf(ss * (1.f / D) + EPS);
        float a = -INFINITY, b = -INFINITY, sa = 0.f, sb = 0.f; int ia = 0, ib = 0;
#pragma unroll
        for (int k = 0; k < 4; ++k) { const float scv = 1.f / (1.f + expf(-acc[k] * r)); const float v = scv + bv[k]; const int e = quad * 4 + k;
            if (v > a) { b = a; ib = ia; sb = sa; a = v; ia = e; sa = scv; } else if (v > b) { b = v; ib = e; sb = scv; } }
        const float gs = a + b;
        int best = 0; float bestv = __shfl(gs, fr);
#pragma unroll
        for (int g = 1; g < 4; ++g) { const float v = __shfl(gs, fr + 16 * g); if (v > bestv) { bestv = v; best = g; } }
        if (quad == best) { const float inv = 1.f / (sa + sb); u32x4 ti4; ti4.x = (unsigned)ia; ti4.y = (unsigned)ib; ti4.z = __float_as_uint(sa * inv); ti4.w = __float_as_uint(sb * inv);
            *(u32x4*)(ws + WS_TOKINFO + (size_t)tok * 16) = ti4; ((float*)(ws + WS_RS))[tok] = r; atomicAdd((int*)&hist[ia], 1); atomicAdd((int*)&hist[ib], 1); }
        __syncthreads();
        if (tid < 16) ((int*)(ws + WS_CHUNKCNT))[ch * 16 + tid] = hist[tid];
        __syncthreads();
    }
}

__device__ __forceinline__ void lists_phase(const Params& p, LAS int* sm, int b0, int nb) {
    unsigned char* ws = p.ws; int tid = threadIdx.x; asm volatile("" : "+v"(tid));
    const int* cc = (const int*)(ws + WS_CHUNKCNT); int* rowtok = (int*)(ws + WS_ROWTOK); float* rowwt = (float*)(ws + WS_ROWWT); float* rowrs = (float*)(ws + WS_ROWRS);
    int* pos = (int*)(ws + WS_POS); const float* rs = (const float*)(ws + WS_RS);
    LAS int* part = sm;
    LAS int* tot = sm + 512;
    LAS int* start = sm + 528;
    LAS int* base = sm + 560;
    LAS int* e0s = sm + 576;
    LAS int* e1s = sm + 704;
    for (int ch = b0; ch < NTOK / 128; ch += nb) {
        { const int e = tid & 15, pt = tid >> 4; int s = 0; for (int c = pt * 8; c < pt * 8 + 8; ++c) s += cc[c * 16 + e]; part[pt * 16 + e] = s; }
        __syncthreads();
        if (tid < 16) { int s = 0; for (int pt = 0; pt < 32; ++pt) s += part[pt * 16 + tid]; tot[tid] = s; }
        __syncthreads();
        if (tid == 0) { int s = 0; for (int e = 0; e < 16; ++e) { start[e] = s; s += ((tot[e] + 255) >> 8) << 8; } start[16] = s; }
        __syncthreads();
        if (tid < 16) { int s = start[tid]; const int pf = ch >> 3; for (int pt = 0; pt < pf; ++pt) s += part[pt * 16 + tid]; for (int c = pf * 8; c < ch; ++c) s += cc[c * 16 + tid]; base[tid] = s; }
        if (tid < 128) { const u32x4 ti = *(const u32x4*)(ws + WS_TOKINFO + (size_t)(ch * 128 + tid) * 16); e0s[tid] = (int)ti.x; e1s[tid] = (int)ti.y; }
        __syncthreads();
        if (tid < 128) {
            const int tok = ch * 128 + tid; const u32x4 ti = *(const u32x4*)(ws + WS_TOKINFO + (size_t)tok * 16);
            const int e0 = (int)ti.x, e1 = (int)ti.y; int r0 = 0, r1 = 0;
            for (int j = 0; j < tid; ++j) { const int a = e0s[j], b = e1s[j]; r0 += (a == e0 || b == e0) ? 1 : 0; r1 += (a == e1 || b == e1) ? 1 : 0; }
            const int p0 = base[e0] + r0, p1 = base[e1] + r1; const float r = rs[tok];
            rowtok[p0] = tok; rowwt[p0] = __uint_as_float(ti.z); rowrs[p0] = r; rowtok[p1] = tok; rowwt[p1] = __uint_as_float(ti.w); rowrs[p1] = r;
            pos[tok * 2] = p0; pos[tok * 2 + 1] = p1;
        }
        if (ch < 16) {
            const int e = ch, s0 = start[e] + tot[e], s1 = start[e + 1];
            for (int r = s0 + tid; r < s1; r += NTHREADS) { rowtok[r] = 0; rowwt[r] = 0.f; rowrs[r] = 0.f; }
            for (int t = (start[e] >> 8) + tid; t < (s1 >> 8); t += NTHREADS) ((int*)(ws + WS_TILEEXP))[t] = e;
            if (e == 0 && tid == 0) *(int*)(ws + WS_NTILES) = start[16] >> 8;
        }
        __syncthreads();
    }
}

struct CombRows { u32x2 xa[4]; unsigned ya[4], yb[4]; };
__device__ __forceinline__ void comb_load(CombRows& r, const unsigned char* ws, int tok, int p0, int p1, int lane) {
    const u32x2* xr = (const u32x2*)((const bf16_t*)(ws + WS_XB) + (size_t)tok * D) + lane; const unsigned char* ys = ws + WS_BIG + BG_YSLOT;
    const unsigned* y0 = (const unsigned*)(ys + (size_t)p0 * D) + lane; const unsigned* y1 = (const unsigned*)(ys + (size_t)p1 * D) + lane;
#pragma unroll
    for (int j = 0; j < 4; ++j) { r.xa[j] = xr[64 * j]; r.ya[j] = y0[64 * j]; r.yb[j] = y1[64 * j]; }
}
__device__ __forceinline__ void comb_finish(const Params& p, const CombRows& c, const f32x4 (&gfv)[4], int l, int tok, int lane) {
    unsigned char* ws = p.ws;
    f32x4 v[4]; float s = 0.f;
#pragma unroll
    for (int j = 0; j < 4; ++j) {
        const f32x2 a01 = __builtin_amdgcn_cvt_pk_f32_fp8((int)c.ya[j], false), a23 = __builtin_amdgcn_cvt_pk_f32_fp8((int)c.ya[j], true), b01 = __builtin_amdgcn_cvt_pk_f32_fp8((int)c.yb[j], false), b23 = __builtin_amdgcn_cvt_pk_f32_fp8((int)c.yb[j], true);
        constexpr float ysc = 1.f / YS8_SCALE;
        v[j].x = __uint_as_float(c.xa[j].x << 16) + (a01[0] + b01[0]) * ysc; v[j].y = __uint_as_float(c.xa[j].x & 0xffff0000u) + (a01[1] + b01[1]) * ysc;
        v[j].z = __uint_as_float(c.xa[j].y << 16) + (a23[0] + b23[0]) * ysc; v[j].w = __uint_as_float(c.xa[j].y & 0xffff0000u) + (a23[1] + b23[1]) * ysc;
        s += (v[j].x * v[j].x + v[j].y * v[j].y) + (v[j].z * v[j].z + v[j].w * v[j].w); }
    s = wave_sum(s); const float r = 1.0f / sqrtf(s * (1.f / D) + EPS);
    if (l == DEPTH - 1) {
        f32x4* orow = (f32x4*)(p.out + (size_t)tok * D) + lane;
#pragma unroll
        for (int j = 0; j < 4; ++j) orow[64 * j] = v[j] * r * gfv[j];
    } else {
        u32x2* xr = (u32x2*)((bf16_t*)(ws + WS_XB) + (size_t)tok * D) + lane;
        u32x2 w[4]; float s2 = 0.f, am = 0.f;
#pragma unroll
        for (int j = 0; j < 4; ++j) { w[j].x = pk2(v[j].x, v[j].y); w[j].y = pk2(v[j].z, v[j].w);
            const float a0 = __uint_as_float(w[j].x << 16), a1 = __uint_as_float(w[j].x & 0xffff0000u), a2 = __uint_as_float(w[j].y << 16), a3 = __uint_as_float(w[j].y & 0xffff0000u); s2 += (a0 * a0 + a1 * a1) + (a2 * a2 + a3 * a3); xr[64 * j] = w[j];
            am = fmaxf(am, fmaxf(fmaxf(fabsf(a0), fabsf(a1)), fmaxf(fabsf(a2), fabsf(a3)))); }
        s2 = wave_sum(s2); am = fmaxf(wave_max(am), 1e-30f); const float inv = 127.f / am;
        unsigned* q = (unsigned*)(ws + WS_XB8 + (size_t)tok * D) + lane;
#pragma unroll
        for (int j = 0; j < 4; ++j) q[64 * j] = pk4_i8(__uint_as_float(w[j].x << 16) * inv, __uint_as_float(w[j].x & 0xffff0000u) * inv, __uint_as_float(w[j].y << 16) * inv, __uint_as_float(w[j].y & 0xffff0000u) * inv);
        if (lane == 0) ((float*)(ws + WS_RS))[tok] = am * (1.f / 127.f) / sqrtf(s2 * (1.f / D) + EPS);
    }
}
__device__ __forceinline__ void combine_phase(const Params& p, int l, int gw, int ngw, int lane) {
    const unsigned char* ws = p.ws; const int* pos = (const int*)(ws + WS_POS);
    constexpr int CB = 4;
    f32x4 gfv[4];
#pragma unroll
    for (int j = 0; j < 4; ++j) gfv[j] = (l == DEPTH - 1) ? ((const f32x4*)p.in[18] + lane)[64 * j] : (f32x4){0.f, 0.f, 0.f, 0.f};
    int pp[CB][2];
#pragma unroll
    for (int k = 0; k < CB; ++k) { const int tk = gw + k * ngw; pp[k][0] = 0; pp[k][1] = 0; if (tk < NTOK) { pp[k][0] = pos[tk * 2]; pp[k][1] = pos[tk * 2 + 1]; } }
#pragma unroll 1
    for (int tb = gw; tb < NTOK; tb += CB * ngw) {
#pragma unroll
        for (int k = 0; k < CB; ++k) asm volatile("" : "+v"(pp[k][0]), "+v"(pp[k][1]));
        int pn[CB][2];
#pragma unroll
        for (int k = 0; k < CB; ++k) { const int tn = tb + (CB + k) * ngw; pn[k][0] = 0; pn[k][1] = 0; if (tn < NTOK) { pn[k][0] = pos[tn * 2]; pn[k][1] = pos[tn * 2 + 1]; } }
        CombRows R[CB];
#pragma unroll
        for (int k = 0; k < CB; ++k) { const int tk = tb + k * ngw; if (tk < NTOK) comb_load(R[k], ws, tk, pp[k][0], pp[k][1], lane); }
        __builtin_amdgcn_sched_barrier(0);
#pragma unroll
        for (int k = 0; k < CB; ++k) { const int tk = tb + k * ngw; if (tk < NTOK) comb_finish(p, R[k], gfv, l, tk, lane); }
#pragma unroll
        for (int k = 0; k < CB; ++k) { pp[k][0] = pn[k][0]; pp[k][1] = pn[k][1]; }
    }
}

#define XB_TMO      128
#define XB_XCNT(j)  (256  + 64 * (j))
#define XB_XSUB(j)  (1280 + 64 * (j))
#define XB_XGEN(j)  (2304 + 64 * (j))
#define XB_TOP      3328
#define XB_TOPGEN   3392
#define XCD_BAR_WORDS 3456
#define XB_SPIN_CAP (1u << 18)
__device__ __forceinline__ unsigned xb_ld(unsigned* p)              { return __hip_atomic_load(p, __ATOMIC_RELAXED, __HIP_MEMORY_SCOPE_AGENT); }
__device__ __forceinline__ unsigned xb_add(unsigned* p, unsigned v) { return __hip_atomic_fetch_add(p, v, __ATOMIC_RELAXED, __HIP_MEMORY_SCOPE_AGENT); }
__device__ __forceinline__ unsigned xb_xcc_id() { return (unsigned)__builtin_amdgcn_s_getreg((3 << 11) | 20) & 0xFu; }
#define XB_SPIN(cond, bar) do { unsigned _sp = 0; while (cond) { __builtin_amdgcn_s_sleep(1); \
    if ((++_sp & 255u) == 0u) { if (xb_ld(&(bar)[XB_TMO])) break; if (_sp > XB_SPIN_CAP) { atomicAdd(&(bar)[XB_TMO], 1u); break; } } } } while (0)
struct XcdBarrier { unsigned* bar; unsigned x; volatile LAS unsigned* st; };
__device__ __forceinline__ XcdBarrier xcd_barrier_post(unsigned* bar, volatile LAS unsigned* st) {
    XcdBarrier b; b.bar = bar; b.x = xb_xcc_id(); b.st = st;
    if (threadIdx.x == 0) (void)xb_add(&bar[XB_XCNT(b.x)], 1u);
    return b;
}
__device__ __forceinline__ void xcd_barrier_complete(unsigned* bar, unsigned x, unsigned& nloc, unsigned& nx) {
    const unsigned G = gridDim.x * gridDim.y * gridDim.z;
    unsigned sum, cnt, mine, sp = 0u;
    for (;;) {
        sum = 0u; cnt = 0u; mine = 0u;
#pragma unroll
        for (unsigned j = 0; j < 16; ++j) { const unsigned c = xb_ld(&bar[XB_XCNT(j)]); sum += c; cnt += (c > 0u) ? 1u : 0u; mine = (j == x) ? c : mine; }
        if (sum == G) break;
        __builtin_amdgcn_s_sleep(1);
        if ((++sp & 255u) == 0u) { if (xb_ld(&bar[XB_TMO])) break; if (sp > XB_SPIN_CAP) { atomicAdd(&bar[XB_TMO], 1u); break; } }
    }
    nloc = mine > 0u ? mine : 1u; nx = cnt > 0u ? cnt : 1u;
}
__device__ __forceinline__ void xcd_barrier(const XcdBarrier& b) {
    asm volatile("s_waitcnt vmcnt(0)" ::: "memory");
    __syncthreads();
    if (threadIdx.x == 0) {
        unsigned* bar = b.bar;
        __builtin_amdgcn_s_waitcnt(0);
        unsigned nloc = b.st[0], nx = b.st[1];
        if (nloc == 0u) { xcd_barrier_complete(bar, b.x, nloc, nx); b.st[0] = nloc; b.st[1] = nx; }
        const unsigned old = xb_add(&bar[XB_XSUB(b.x)], 1u);
        const unsigned gen = old / nloc;
        if (old + 1u == (gen + 1u) * nloc) {
            __builtin_amdgcn_fence(__ATOMIC_RELEASE, "agent");
            asm volatile("s_waitcnt vmcnt(0)" ::: "memory");
            const unsigned og = xb_add(&bar[XB_TOP], 1u);
            const unsigned tg = og / nx;
            if (og + 1u == (tg + 1u) * nx) xb_add(&bar[XB_TOPGEN], 1u);
            else XB_SPIN(xb_ld(&bar[XB_TOPGEN]) == tg, bar);
            __builtin_amdgcn_fence(__ATOMIC_ACQUIRE, "agent");
            xb_add(&bar[XB_XGEN(b.x)], 1u);
            asm volatile("s_waitcnt vmcnt(0)" ::: "memory");
        } else {
            XB_SPIN(xb_ld(&bar[XB_XGEN(b.x)]) == gen, bar);
            __builtin_amdgcn_fence(__ATOMIC_ACQUIRE, "agent");
            asm volatile("s_waitcnt vmcnt(0)" ::: "memory");
        }
    }
    __syncthreads();
}

constexpr size_t WS_BAR = 16384;
typedef const __attribute__((address_space(4))) Params* KParamsPtr;
__device__ __forceinline__ KParamsPtr kparams() { KParamsPtr kp = (KParamsPtr)__builtin_amdgcn_kernarg_segment_ptr(); asm volatile("" : "+s"(kp)); return kp; }
#define PP (*(const Params*)kparams())
__global__ void __launch_bounds__(NTHREADS, 2) k_mega(Params p_unused) {
    extern __shared__ __attribute__((aligned(16))) unsigned char lds_raw[];
    LAS unsigned char* lds = (LAS unsigned char*)lds_raw;
    volatile LAS unsigned* bst = (volatile LAS unsigned*)(lds + LDS_BYTES - 64);
    if (threadIdx.x == 0) { bst[0] = 0u; bst[1] = 0u; }
    __syncthreads();
    (void)xcd_barrier_post((unsigned*)(PP.ws + WS_BAR), bst);
#define GRID_BAR() xcd_barrier(XcdBarrier{(unsigned*)(PP.ws + WS_BAR), xb_xcc_id(), bst})
    const int b0 = blockIdx.x, nb = gridDim.x, ngw = nb * 8;
#define MK_LANE ({ int t_ = threadIdx.x; asm volatile("" : "+v"(t_)); t_ & 63; })
#define MK_GW ({ int t_ = threadIdx.x; asm volatile("" : "+v"(t_)); b0 * 8 + (t_ >> 6); })
    setup_phase(PP, b0, nb);
    wmax_phase(PP, b0, nb);
    convert_mem_phase(PP, (LAS float*)lds, b0, nb);
    prep_phase(PP, MK_GW, ngw, MK_LANE);
    GRID_BAR();
    if (b0 < 64) {
#pragma unroll 1
        for (int u = b0; u < 64; u += (nb > 64 ? 64 : nb)) phase_memkv(PP, lds, u >> 5, u & 31, 32);
    }
    { constexpr int NCV = 2 * CT_LAYER, N1 = 4032; const bool wsplit = nb > 128;
      const int ci0 = !wsplit ? b0 : (b0 < 64 ? N1 + b0 : b0 - 64), cst = !wsplit ? nb : (b0 < 64 ? 64 : nb - 64), chi = (wsplit && b0 >= 64) ? N1 : NCV;
      convert_phase(PP, (LAS float*)lds, ci0, cst, chi); }
    GRID_BAR();
#pragma unroll 1
    for (int l = 0; l < DEPTH; ++l) {
#pragma unroll 1
        for (int half = 0; half < 2; ++half) {
            phase_mix(PP, lds, l, half);
            GRID_BAR();
            phase_hgrnA(PP, lds, b0, nb);
            GRID_BAR();
            phase_diff(PP, lds, l, half);
            GRID_BAR();
            phase_gates(PP, lds, l, half);
            phase_merge(PP, lds, l, half);
            GRID_BAR();
        }
        phase_out(PP, lds, l);
        GRID_BAR();
        route_phase(PP, l, lds, b0, nb);
        GRID_BAR();
        lists_phase(PP, (LAS int*)lds, b0, nb);
        GRID_BAR();
        phase_gateup(PP, lds, l);
        GRID_BAR();
        phase_down(PP, lds, l);
        GRID_BAR();
        combine_phase(PP, l, MK_GW, ngw, MK_LANE);
        if (l + 1 < DEPTH) GRID_BAR();
    }
}

extern "C" void kernel_launch(void* const* d_in, const int* in_sizes, int n_in, void* d_out, int out_size, void* d_ws, size_t ws_size, hipStream_t stream) {
    static int grid = 0;
    if (grid == 0) {
        if (n_in != 19 || ws_size < WS_END) { fprintf(stderr, "kernel_launch: unexpected inputs (n_in %d, ws %zu)\n", n_in, ws_size); grid = -1; return; }
        int dev = 0, cus = 0, per_cu = 0;
        if (hipGetDevice(&dev) != hipSuccess || hipDeviceGetAttribute(&cus, hipDeviceAttributeMultiprocessorCount, dev) != hipSuccess) { grid = -1; return; }
        if (hipFuncSetAttribute((const void*)k_mega, hipFuncAttributeMaxDynamicSharedMemorySize, LDS_BYTES) != hipSuccess) { fprintf(stderr, "kernel_launch: hipFuncSetAttribute failed\n"); grid = -1; return; }
        if (hipOccupancyMaxActiveBlocksPerMultiprocessor(&per_cu, (const void*)k_mega, NTHREADS, LDS_BYTES) != hipSuccess || per_cu < 1) { fprintf(stderr, "kernel_launch: occupancy query reports %d\n", per_cu); }
        (void)hipGetLastError();
        grid = cus;
    }
    if (grid < 0) return;
    Params p{};
    for (int i = 0; i < 19; ++i) p.in[i] = (const float*)d_in[i];
    p.out = (float*)d_out; p.ws = (unsigned char*)d_ws; p.l = 0; p.half = 0;
    (void)hipMemsetAsync(d_ws, 0, 1 * MiB, stream);
    hipLaunchKernelGGL(k_mega, dim3(grid), dim3(NTHREADS), LDS_BYTES, stream, p);
}
```

```cpp
#include <hip/hip_runtime.h>
#include <cstdio>
#include <cstdint>

#define LAS __attribute__((address_space(3)))
typedef unsigned short bf16_t;
typedef short bf16x8 __attribute__((ext_vector_type(8)));
typedef float f32x4 __attribute__((ext_vector_type(4)));
typedef float f32x2 __attribute__((ext_vector_type(2)));
typedef unsigned u32x4 __attribute__((ext_vector_type(4)));
typedef unsigned u32x2 __attribute__((ext_vector_type(2)));

constexpr int D = 1024, NBATCH = 8, SEQ = 4096, NTOK = NBATCH * SEQ, DEPTH = 2, MEMLEN = 256, NMEM = NBATCH * MEMLEN;
constexpr int HT = NTOK / 2;
constexpr int HB = NBATCH / 2;
constexpr int NE = 16, DE = 512;
constexpr int IN_TOTAL = 7168, MIXW = 4096, GATEW = 3072;
constexpr float EPS = 1e-6f;
constexpr float LOG2E = 1.4426950408889634f;
constexpr int MAXROWS = 65536 + NE * 256;

constexpr size_t MiB = 1u << 20;
constexpr size_t WS_CTL = 0;
constexpr size_t WS_LAM = 1 * MiB;
constexpr size_t WS_LBS = 1 * MiB + 4096;
constexpr size_t WS_WRT = 1 * MiB + 65536;
constexpr size_t WS_RS = 1 * MiB + 262144;
constexpr size_t WS_RSMEM = 1 * MiB + 393216;
constexpr size_t WS_TOKINFO = 1 * MiB + 524288;
constexpr size_t WS_CHUNKCNT = 2 * MiB;
constexpr size_t WS_TILEEXP = 2 * MiB + 16384;
constexpr size_t WS_NTILES = 2 * MiB + 20480;
constexpr size_t WS_ROWTOK = 2 * MiB + 65536;
constexpr size_t WS_ROWWT = 2 * MiB + 65536 + 327680;
constexpr size_t WS_ROWRS = 2 * MiB + 65536 + 2 * 327680;
constexpr size_t WS_POS = 3 * MiB + 524288;
constexpr size_t WS_MEMB = 4 * MiB;
constexpr size_t WS_XB = 8 * MiB;
constexpr size_t WS_BIG = 72 * MiB;
constexpr size_t WS_ST = 328 * MiB;
constexpr size_t WS_MKV = 344 * MiB;
constexpr size_t WS_WMIX = 352 * MiB;
constexpr size_t WMIX_LAYER = 21 * MiB, WMIX_BR = 14 * MiB, WMIX_OUT = 17 * MiB, WMIX_MEM = 19 * MiB;
constexpr size_t WS_WMOE = 394 * MiB;
constexpr size_t WMOE_LAYER = 24 * MiB, WMOE_D = 16 * MiB;
constexpr size_t WS_XB8 = 442 * MiB;
constexpr float YS8_SCALE = 16.f;
constexpr float W8_SCALE = 64.f, ACT8_SCALE = 8.f;
constexpr size_t WS_END = 490 * MiB;
constexpr size_t WS_KM2 = 262144;
constexpr size_t WS_WMAX = 393216;
constexpr size_t WS_WSC = 1 * MiB + 409600;
constexpr size_t WS_HGCNT = 196608, WS_SPINTMO = 10240;
constexpr size_t BG_PB = 0;
constexpr size_t PB_STRIDE = (size_t)HT * 512 * 2;
constexpr size_t BG_LOGF = 112 * MiB;
constexpr size_t BG_YCAT = 144 * MiB;
constexpr size_t BG_GATES = 0;
constexpr size_t BG_MERGED = 192 * MiB;
constexpr size_t BG_ACT = 0;
constexpr size_t BG_YSLOT = 68 * MiB;
enum { SL_QA = 0, SL_KA = 1, SL_VA = 2, SL_HQ = 3, SL_HV = 4, SL_HG = 5, SL_CQ = 6 };

struct Params {
    const float* in[19];
    float* out;
    unsigned char* ws;
    int l, half;
};

__device__ __forceinline__ float bf2f(bf16_t b) { return __uint_as_float(((unsigned)b) << 16); }
__device__ __forceinline__ unsigned f2bf(float f) { unsigned u = __float_as_uint(f); return (u + 0x7fffu + ((u >> 16) & 1u)) >> 16; }
typedef __bf16 bf16x2_t __attribute__((ext_vector_type(2)));
__device__ __forceinline__ unsigned cvt_pk_bf16(float lo, float hi) { const f32x2 v = {lo, hi}; return __builtin_bit_cast(unsigned, __builtin_convertvector(v, bf16x2_t)); }
__device__ __forceinline__ unsigned pk2(float lo, float hi) { return cvt_pk_bf16(lo, hi); }
__device__ __forceinline__ unsigned pk4_fp8(float a, float b, float c, float d) { int w = 0; w = __builtin_amdgcn_cvt_pk_fp8_f32(a, b, w, false); w = __builtin_amdgcn_cvt_pk_fp8_f32(c, d, w, true); return (unsigned)w; }
__device__ __forceinline__ unsigned pk4_i8(float a, float b, float c, float d) {
    const int ia = __float2int_rn(fminf(fmaxf(a, -127.f), 127.f)), ib = __float2int_rn(fminf(fmaxf(b, -127.f), 127.f)), ic = __float2int_rn(fminf(fmaxf(c, -127.f), 127.f)), id = __float2int_rn(fminf(fmaxf(d, -127.f), 127.f));
    return (unsigned)(ia & 255) | ((unsigned)(ib & 255) << 8) | ((unsigned)(ic & 255) << 16) | ((unsigned)id << 24); }
__device__ __forceinline__ float fsigmoid(float z) { return __builtin_amdgcn_rcpf(1.f + __expf(-z)); }
__device__ __forceinline__ float fsilu(float z) { return z * fsigmoid(z); }
__device__ __forceinline__ void lds_barrier() { asm volatile("s_waitcnt lgkmcnt(0)" ::: "memory"); __builtin_amdgcn_s_barrier(); asm volatile("" ::: "memory"); }
template <int CTRL> __device__ __forceinline__ float dppf(float v) { return __int_as_float(__builtin_amdgcn_update_dpp(0, __float_as_int(v), CTRL, 0xF, 0xF, true)); }
__device__ __forceinline__ float rlanef(float v, int l) { return __int_as_float(__builtin_amdgcn_readlane(__float_as_int(v), l)); }
__device__ __forceinline__ float wave_sum(float v) {
    v += dppf<0xB1>(v); v += dppf<0x4E>(v); v += dppf<0x141>(v); v += dppf<0x140>(v);
    return (rlanef(v, 0) + rlanef(v, 16)) + (rlanef(v, 32) + rlanef(v, 48));
}
__device__ __forceinline__ float wave_max(float v) {
    v = fmaxf(v, dppf<0xB1>(v)); v = fmaxf(v, dppf<0x4E>(v)); v = fmaxf(v, dppf<0x141>(v)); v = fmaxf(v, dppf<0x140>(v));
    return fmaxf(fmaxf(rlanef(v, 0), rlanef(v, 16)), fmaxf(rlanef(v, 32), rlanef(v, 48)));
}

namespace pg8 {
constexpr int BM = 256, BK = 64, HALF = 128, HTB = HALF * BK * 2, STAGE_BYTES = 8 * HTB, NXCD = 8, WGM = 8;
__host__ __device__ __forceinline__ int lds_byte(int r, int c) { const int st = (r >> 4) * 2 + (c >> 5), rr = r & 15, cc = c & 31, ob = rr * 64 + cc * 2; return st * 1024 + (ob ^ (((ob >> 9) & 1) << 5)); }
__host__ __device__ __forceinline__ void stage_rc(int b, int& R, int& C) { const int st = b / 1024, sb = b % 1024, swz = sb ^ (((sb >> 9) & 1) << 5); R = (st >> 1) * 16 + swz / 64; C = (st & 1) * 32 + (swz % 64) / 2; }
__host__ __device__ __forceinline__ int perm32(int rho) { const int n = rho >> 4, i = rho & 15; return 8 * (i >> 2) + 4 * n + (i & 3); }

struct Unit { int pm, pn; };
struct Gemm { const bf16_t* A; const bf16_t* Bt; int K; const float* cs; };

struct StaticOrder {
    static constexpr bool GATHER = false;
    int nM, nN, nwg, G, c;
    __device__ void init(int M, int N, int G_, int c_) { nM = M / BM; nN = N / BM; nwg = nM * nN; G = G_; c = c_; }
    __device__ bool next(int i, Unit& u) const {
        const long L = (long)i * G + c; if (L >= nwg) return false;
        int wgid = (int)L; { const int q = nwg / NXCD, r = nwg % NXCD, xcd = wgid % NXCD, off = wgid / NXCD; wgid = (xcd < r ? xcd * (q + 1) : r * (q + 1) + (xcd - r) * q) + off; }
        const int nig = WGM * nN, gid = wgid / nig, fm = gid * WGM, gsz = (nM - fm) < WGM ? (nM - fm) : WGM;
        u.pm = fm + ((wgid % nig) % gsz); u.pn = (wgid % nig) / gsz; return true;
    }
    __device__ __forceinline__ size_t b_off(const Unit& u, size_t tstep) const { return (size_t)u.pn * tstep; }
    __device__ __forceinline__ int b_key(const Unit&) const { return 0; }
    __device__ __forceinline__ size_t b_off_k(int, const Unit& u, size_t tstep) const { return (size_t)u.pn * tstep; }
    __device__ __forceinline__ int row(const Unit&, int) const { return 0; }
};
struct GatesOfMerge : StaticOrder {
    __device__ bool next(int i, Unit& u) const { Unit mu; if (!StaticOrder::next(i / 3, mu)) return false; u.pm = mu.pm; u.pn = mu.pn + 4 * (i % 3); return true; }
};
template <bool GATH> struct MoeOrder : StaticOrder {
    static constexpr bool GATHER = GATH;
    const int* tile_exp; const int* rowtok; size_t estride;
    __device__ __forceinline__ size_t b_off(const Unit& u, size_t tstep) const { return (size_t)tile_exp[u.pm] * estride + (size_t)u.pn * tstep; }
    __device__ __forceinline__ int b_key(const Unit& u) const { return tile_exp[u.pm]; }
    __device__ __forceinline__ size_t b_off_k(int key, const Unit& u, size_t tstep) const { return (size_t)key * estride + (size_t)u.pn * tstep; }
    __device__ __forceinline__ int row(const Unit& u, int r) const { return rowtok[u.pm * BM + r]; }
};

typedef f32x4 Acc[2][2][4][2];

__device__ __forceinline__ const char* uni_ptr(const char* p) { const unsigned long long v = (unsigned long long)p; const unsigned lo = __builtin_amdgcn_readfirstlane((unsigned)v), hi = __builtin_amdgcn_readfirstlane((unsigned)(v >> 32)); return (const char*)(((unsigned long long)hi << 32) | lo); }
template <class Epi, class Sched, bool ALIGN_EPI, int QM = 0>
__device__ __forceinline__ void gemm_phase(LAS unsigned char* lds, const Gemm g, const Sched& S, const Epi& E) {
    constexpr bool GATHER = Sched::GATHER, FP8 = QM == 1, I8 = QM == 2; static_assert(!I8 || Epi::PERM, "int8 flavour: PERM column map");
    int tid = threadIdx.x; asm volatile("" : "+v"(tid));
    const int wid = __builtin_amdgcn_readfirstlane(tid >> 6), lane = tid & 63, wr = wid >> 2, wc = wid & 3, fr = lane & 15, fq = lane >> 4;
    const int K = g.K, nt = K / BK;
    unsigned voffB[2]; int Rr[2], Cc[2];
#pragma unroll
    for (int i = 0; i < 2; ++i) { int R, C; stage_rc(tid * 16 + i * 8192, R, C); Rr[i] = R; Cc[i] = C; const int Rb = Epi::PERM ? ((R & ~31) + perm32(R & 31)) : R;
        voffB[i] = (unsigned)(Rb * K + C) * 2u; }
    const size_t kstep = (size_t)(BK * 2);
    const size_t hstep = (size_t)HALF * K * 2;
    const size_t tstep = 2 * hstep;
    const unsigned ldsw = (unsigned)wid * 1024u;
    const int aoff = lds_byte(wr * 64 + fr, fq * 8), boff = lds_byte(wc * 32 + fr, fq * 8);
#define PG8_SA(b, h) (((b) * 2 + (h)) * HTB)
#define PG8_SB(b, h) ((4 + (b) * 2 + (h)) * HTB)
#define PG8_STAGE(bufoff, gbase, voff) do { _Pragma("unroll") for (int _i = 0; _i < 2; ++_i) \
        __builtin_amdgcn_global_load_lds((const unsigned*)((const char*)(gbase) + (voff)[_i]), (LAS unsigned*)(lds + (bufoff) + ldsw + _i * 8192), 16, 0, 0); } while (0)
#define PG8_STAGEA(bufoff, gbase, v, h) do { _Pragma("unroll") for (int _i = 0; _i < 2; ++_i) \
        __builtin_amdgcn_global_load_lds((const unsigned*)((const char*)(gbase) + (v)[h][_i]), (LAS unsigned*)(lds + (bufoff) + ldsw + _i * 8192), 16, 0, 0); } while (0)
#define PG8_SETA(v, u) do { _Pragma("unroll") for (int _h = 0; _h < 2; ++_h) _Pragma("unroll") for (int _i = 0; _i < 2; ++_i) \
        (v)[_h][_i] = GATHER ? (unsigned)(S.row((u), _h * HALF + Rr[_i]) * K + Cc[_i]) * 2u : (unsigned)((_h * HALF + Rr[_i]) * K + Cc[_i]) * 2u; \
        asm volatile("" : "+v"((v)[0][0]), "+v"((v)[0][1]), "+v"((v)[1][0]), "+v"((v)[1][1])); } while (0)
    typedef int v8i_ __attribute__((ext_vector_type(8))); typedef int v4i_ __attribute__((ext_vector_type(4)));
#define PG8_LD2(p_) (__builtin_shufflevector(*(const LAS v4i_*)(p_), *(const LAS v4i_*)((p_) + 1024), 0, 1, 2, 3, 4, 5, 6, 7))
#define PG8_LDA(dst, b, h) do { _Pragma("unroll") for (int m = 0; m < 4; ++m) { if constexpr (FP8) dst##8[m] = PG8_LD2(lds + PG8_SA(b, h) + aoff + m * 2048); else { _Pragma("unroll") for (int k = 0; k < 2; ++k) dst[m][k] = *(const LAS bf16x8*)(lds + PG8_SA(b, h) + aoff + m * 2048 + k * 1024); } } } while (0)
#define PG8_LDB(dst, b, h) do { _Pragma("unroll") for (int n = 0; n < 2; ++n) { if constexpr (FP8) dst##8[n] = PG8_LD2(lds + PG8_SB(b, h) + boff + n * 2048); else { _Pragma("unroll") for (int k = 0; k < 2; ++k) dst[n][k] = *(const LAS bf16x8*)(lds + PG8_SB(b, h) + boff + n * 2048 + k * 1024); } } } while (0)
#define PG8_MMA(ai, bj, At, Bt) do { __builtin_amdgcn_s_setprio(1); _Pragma("unroll") for (int m = 0; m < 4; ++m) _Pragma("unroll") for (int n = 0; n < 2; ++n) { \
        if constexpr (FP8) { asm volatile("v_mfma_scale_f32_16x16x128_f8f6f4 %0, %1, %2, %0, %3, %3 op_sel_hi:[0,0,0]" : "+v"(acc[ai][bj][m][n]) : "v"(Bt##8[n]), "v"(At##8[m]), "v"(mx_one)); } \
        else if constexpr (I8) { _Pragma("unroll") for (int k = 0; k < 2; ++k) acc[ai][bj][m][n] = __builtin_bit_cast(f32x4, __builtin_amdgcn_mfma_i32_16x16x64_i8(__builtin_bit_cast(v4i_, Bt[n][k]), __builtin_bit_cast(v4i_, At[m][k]), __builtin_bit_cast(v4i_, acc[ai][bj][m][n]), 0, 0, 0)); } \
        else { _Pragma("unroll") for (int k = 0; k < 2; ++k) acc[ai][bj][m][n] = __builtin_amdgcn_mfma_f32_16x16x32_bf16(Bt[n][k], At[m][k], acc[ai][bj][m][n], 0, 0, 0); } } \
        __builtin_amdgcn_s_setprio(0); } while (0)
#define PG8_WAIT_V(n) asm volatile("s_waitcnt vmcnt(" #n ")" ::: "memory")
#define PG8_WAIT_L(n) asm volatile("s_waitcnt lgkmcnt(" #n ")" ::: "memory")
#define PG8_BAR __builtin_amdgcn_s_barrier()
#define PG8_SCHED __builtin_amdgcn_sched_barrier(0)
    Unit cur, nxt; int ui = 0;
    if (!S.next(0, cur)) return;
    Acc acc;
#pragma unroll
    for (int a = 0; a < 2; ++a)
#pragma unroll
        for (int b = 0; b < 2; ++b)
#pragma unroll
            for (int m = 0; m < 4; ++m)
#pragma unroll
                for (int n = 0; n < 2; ++n) acc[a][b][m][n] = (f32x4){0.f, 0.f, 0.f, 0.f};
    bf16x8 At[4][2], B0[2][2], B1[2][2]; v8i_ At8[4], B08[2], B18[2];
    int mx_one = 0x7f7f7f7f; asm volatile("" : "+v"(mx_one));
    unsigned vA[2][2], vN[2][2];
    PG8_SETA(vA, cur);
    const char* cA = (const char*)g.A + (GATHER ? (size_t)0 : (size_t)cur.pm * tstep); const char* cB = (const char*)g.Bt + S.b_off(cur, tstep);
    PG8_STAGE(PG8_SB(0, 0), cB, voffB); PG8_STAGE(PG8_SB(0, 1), cB + hstep, voffB); PG8_STAGEA(PG8_SA(0, 0), cA, vA, 0); PG8_STAGEA(PG8_SA(0, 1), cA, vA, 1);
    if (wr == 1) PG8_BAR;
    PG8_WAIT_V(2); PG8_BAR;
    PG8_STAGE(PG8_SB(1, 0), cB + kstep, voffB); PG8_STAGEA(PG8_SA(1, 0), cA + kstep, vA, 0); PG8_STAGE(PG8_SB(1, 1), cB + hstep + kstep, voffB);
    PG8_WAIT_V(6); PG8_BAR;
    for (;;) {
        const bool has_next = S.next(ui + 1, nxt);
        const char* nA = has_next ? (const char*)g.A + (GATHER ? (size_t)0 : (size_t)nxt.pm * tstep) : cA; const char* nB = cB;
        int keyN = 0;
        if (has_next) { keyN = S.b_key(nxt);
            if (GATHER) {
#pragma unroll
                for (int h = 0; h < 2; ++h)
#pragma unroll
                    for (int i = 0; i < 2; ++i) vN[h][i] = (unsigned)S.row(nxt, h * HALF + Rr[i]); } }
#pragma unroll 1
        for (int t = 0; t < nt; t += 2) {
            const bool last = (t == nt - 2);
            if constexpr (Epi::MIDK) { if (t == Epi::MID1 || t == Epi::MID2) E.mid(acc, cur, t, wr, wc, fr, fq); }
            const char* a1 = cA + (size_t)(t + 1) * kstep;
            if (last) {
                if (has_next) nB = (const char*)g.Bt + S.b_off_k(__builtin_amdgcn_readfirstlane(keyN), nxt, tstep);
                if (GATHER) {
                    if (has_next) { asm volatile("" : "+v"(vN[0][0]), "+v"(vN[0][1]), "+v"(vN[1][0]), "+v"(vN[1][1])); }
#pragma unroll
                    for (int h = 0; h < 2; ++h)
#pragma unroll
                        for (int i = 0; i < 2; ++i) vN[h][i] = has_next ? (unsigned)((int)vN[h][i] * K + Cc[i]) * 2u : vA[h][i]; }
            }
            const char* a2 = last ? nA : cA + (size_t)(t + 2) * kstep; const char* b2 = last ? nB : cB + (size_t)(t + 2) * kstep;
            const char* a3 = a2 + kstep; const char* b3 = b2 + kstep;
            unsigned w2[2][2];
#pragma unroll
            for (int h = 0; h < 2; ++h)
#pragma unroll
                for (int i = 0; i < 2; ++i) w2[h][i] = (GATHER && last) ? vN[h][i] : vA[h][i];
            PG8_LDB(B0, 0, 0); PG8_LDB(B1, 0, 1); PG8_SCHED; PG8_LDA(At, 0, 0); PG8_STAGEA(PG8_SA(1, 1), a1, vA, 1);
            PG8_WAIT_V(8); PG8_WAIT_L(0); PG8_BAR; PG8_MMA(0, 0, At, B0); PG8_MMA(0, 1, At, B1); PG8_BAR; PG8_SCHED;
            PG8_LDA(At, 0, 1); PG8_STAGE(PG8_SB(0, 0), b2, voffB); PG8_STAGE(PG8_SB(0, 1), b2 + hstep, voffB); PG8_STAGEA(PG8_SA(0, 0), a2, w2, 0);
            PG8_WAIT_V(8); PG8_WAIT_L(0); PG8_BAR; PG8_MMA(1, 0, At, B0); PG8_MMA(1, 1, At, B1); PG8_BAR; PG8_SCHED;
            PG8_LDB(B0, 1, 0); PG8_LDB(B1, 1, 1); PG8_SCHED; PG8_LDA(At, 1, 0); PG8_STAGEA(PG8_SA(0, 1), a2, w2, 1);
            PG8_WAIT_V(8); PG8_WAIT_L(0); PG8_BAR; PG8_MMA(0, 0, At, B0); PG8_MMA(0, 1, At, B1); PG8_BAR; PG8_SCHED;
            PG8_LDA(At, 1, 1); PG8_STAGE(PG8_SB(1, 0), b3, voffB); PG8_STAGE(PG8_SB(1, 1), b3 + hstep, voffB); PG8_STAGEA(PG8_SA(1, 0), a3, w2, 0);
            PG8_WAIT_V(8); PG8_WAIT_L(0); PG8_BAR; PG8_MMA(1, 0, At, B0); PG8_MMA(1, 1, At, B1); PG8_BAR; PG8_SCHED;
        }
        if constexpr (ALIGN_EPI) { if (wr == 0) PG8_BAR; }
        if constexpr (FP8) asm volatile("s_nop 15\n\ts_nop 15\n\ts_nop 7" ::: "memory");
        if constexpr (I8) {
#pragma unroll
            for (int bj = 0; bj < 2; ++bj)
#pragma unroll
                for (int n = 0; n < 2; ++n) { const f32x4 c = *(const f32x4*)(g.cs + cur.pn * BM + bj * HALF + wc * 32 + 8 * fq + 4 * n);
#pragma unroll
                    for (int ai = 0; ai < 2; ++ai)
#pragma unroll
                        for (int m = 0; m < 4; ++m)
#pragma unroll
                            for (int j = 0; j < 4; ++j) acc[ai][bj][m][n][j] = (float)__float_as_int(acc[ai][bj][m][n][j]) * c[j]; } }
        E(acc, cur, wr, wc, fr, fq);
        if (!has_next) break;
#pragma unroll
        for (int a = 0; a < 2; ++a)
#pragma unroll
            for (int b = 0; b < 2; ++b)
#pragma unroll
                for (int m = 0; m < 4; ++m)
#pragma unroll
                    for (int n = 0; n < 2; ++n) acc[a][b][m][n] = (f32x4){0.f, 0.f, 0.f, 0.f};
        cur = nxt; cA = nA; cB = nB; ++ui;
        if (GATHER) {
#pragma unroll
            for (int h = 0; h < 2; ++h)
#pragma unroll
                for (int i = 0; i < 2; ++i) vA[h][i] = vN[h][i]; }
        if constexpr (ALIGN_EPI) { if (wr == 1) PG8_BAR; }
    }
    PG8_WAIT_V(0);
    if constexpr (!ALIGN_EPI) { if (wr == 0) PG8_BAR; }
    PG8_BAR;
#undef PG8_SA
#undef PG8_SB
#undef PG8_STAGE
#undef PG8_STAGEA
#undef PG8_SETA
#undef PG8_LDA
#undef PG8_LD2
#undef PG8_LDB
#undef PG8_MMA
#undef PG8_WAIT_V
#undef PG8_WAIT_L
#undef PG8_BAR
#undef PG8_SCHED
}

__device__ __forceinline__ u32x4 pack8(const f32x4& a, const f32x4& b) { u32x4 w; w.x = cvt_pk_bf16(a[0], a[1]); w.y = cvt_pk_bf16(a[2], a[3]); w.z = cvt_pk_bf16(b[0], b[1]); w.w = cvt_pk_bf16(b[2], b[3]); return w; }

struct EpiMix {
    static constexpr bool PERM = true, MIDK = false; static constexpr int MID1 = -1, MID2 = -1;
    bf16_t* pb; _Float16* logf; const float* rs; const float* lb; float qscale, cqscale; unsigned* kmt;
    __device__ __forceinline__ void operator()(const Acc& acc, const Unit& u, int wr, int wc, int fr, int fq) const {
        float kmx[2][2] = {{0.f, 0.f}, {0.f, 0.f}}; float ka[2][4][2];
        const int type = u.pn >> 1; const int colb = (u.pn & 1) * 256 + wc * 32 + 8 * fq;
        int slot = 0; float sc = 1.f;
        switch (type) { case 0: slot = SL_QA; sc = qscale; break; case 1: slot = SL_KA; break; case 2: slot = SL_VA; break; case 3: slot = SL_HQ; break;
                        case 5: slot = SL_HV; break; case 6: slot = SL_HG; break; case 7: slot = SL_CQ; sc = cqscale; break; default: break; }
        bf16_t* ob = pb + (size_t)slot * HT * 512;
        float rv[2][4];
#pragma unroll
        for (int ai = 0; ai < 2; ++ai)
#pragma unroll
            for (int m = 0; m < 4; ++m) rv[ai][m] = rs[u.pm * BM + ai * HALF + wr * 64 + m * 16 + fr];
        f32x4 lbv[2][2] = {{(f32x4){0.f, 0.f, 0.f, 0.f}, (f32x4){0.f, 0.f, 0.f, 0.f}}, {(f32x4){0.f, 0.f, 0.f, 0.f}, (f32x4){0.f, 0.f, 0.f, 0.f}}};
        if (type == 4) {
#pragma unroll
            for (int bj = 0; bj < 2; ++bj) { lbv[bj][0] = *(const f32x4*)(lb + colb + bj * HALF); lbv[bj][1] = *(const f32x4*)(lb + colb + bj * HALF + 4); } }
#pragma unroll
        for (int ai = 0; ai < 2; ++ai)
#pragma unroll
            for (int m = 0; m < 4; ++m) {
                const int row = u.pm * BM + ai * HALF + wr * 64 + m * 16 + fr; const float r = rv[ai][m];
#pragma unroll
                for (int bj = 0; bj < 2; ++bj) {
                    const int col = colb + bj * HALF;
                    f32x4 v0 = acc[ai][bj][m][0] * r, v1 = acc[ai][bj][m][1] * r;
                    if (type == 4) {
                        const f32x4 l0 = lbv[bj][0], l1 = lbv[bj][1];
#pragma unroll
                        for (int j = 0; j < 4; ++j) { v0[j] = __logf(l0[j] + (1.f - l0[j]) * fsigmoid(v0[j])); v1[j] = __logf(l1[j] + (1.f - l1[j]) * fsigmoid(v1[j])); }
                        typedef _Float16 h16x8 __attribute__((ext_vector_type(8))); h16x8 hv_;
#pragma unroll
                        for (int j = 0; j < 4; ++j) { hv_[j] = (_Float16)v0[j]; hv_[4 + j] = (_Float16)v1[j]; }
                        *(h16x8*)(logf + (size_t)row * 512 + col) = hv_;
                    } else {
                        if (type == 3 || type == 6) {
#pragma unroll
                            for (int j = 0; j < 4; ++j) { v0[j] = fsilu(v0[j]); v1[j] = fsilu(v1[j]); }
                        } else { v0 = v0 * sc; v1 = v1 * sc; }
                        const u32x4 w8 = pack8(v0, v1);
                        *(u32x4*)(ob + (size_t)row * 512 + col) = w8;
                        if (type == 1) {
                            float a = 0.f;
#pragma unroll
                            for (int e = 0; e < 4; ++e) { const float lo = __uint_as_float(w8[e] << 16), hi = __uint_as_float(w8[e] & 0xffff0000u); a += lo * lo + hi * hi; }
                            ka[ai][m][bj] = a;
                        }
                    }
                }
            }
        if (type == 1) {
            { float t_[2][4][2];
#pragma unroll
              for (int sh = 16; sh <= 32; sh <<= 1) {
#pragma unroll
                  for (int ai = 0; ai < 2; ++ai)
#pragma unroll
                      for (int m = 0; m < 4; ++m)
#pragma unroll
                          for (int bj = 0; bj < 2; ++bj) t_[ai][m][bj] = __shfl_xor(ka[ai][m][bj], sh);
                  __builtin_amdgcn_sched_barrier(0);
#pragma unroll
                  for (int ai = 0; ai < 2; ++ai)
#pragma unroll
                      for (int m = 0; m < 4; ++m)
#pragma unroll
                          for (int bj = 0; bj < 2; ++bj) ka[ai][m][bj] += t_[ai][m][bj];
              }
#pragma unroll
              for (int ai = 0; ai < 2; ++ai)
#pragma unroll
                  for (int bj = 0; bj < 2; ++bj) kmx[ai][bj] = fmaxf(fmaxf(ka[ai][0][bj], ka[ai][1][bj]), fmaxf(ka[ai][2][bj], ka[ai][3][bj])); }
#pragma unroll
            for (int ai = 0; ai < 2; ++ai)
#pragma unroll
                for (int bj = 0; bj < 2; ++bj) { float a = kmx[ai][bj];
                    a = fmaxf(a, dppf<0xB1>(a)); a = fmaxf(a, dppf<0x4E>(a)); a = fmaxf(a, dppf<0x141>(a)); a = fmaxf(a, dppf<0x140>(a));
                    if (fr == 0 && fq == 0) { const int tok = u.pm * BM + ai * HALF + wr * 64, bl = tok >> 12, tile = (tok & 4095) >> 6, h = 2 * (u.pn & 1) + bj;
                        __hip_atomic_fetch_max(kmt + ((((bl * 4 + h) * 2 + (wc >> 1)) * 64 + tile) * 2 + (wc & 1)), __float_as_uint(a), __ATOMIC_RELAXED, __HIP_MEMORY_SCOPE_AGENT); } }
        }
    }
};
struct EpiRowFp8 {
    static constexpr bool PERM = true, MIDK = false; static constexpr int MID1 = -1, MID2 = -1;
    unsigned char* O; float cs;
    __device__ __forceinline__ void operator()(const Acc& acc, const Unit& u, int wr, int wc, int fr, int fq) const {
        const int colb = u.pn * BM + wc * 32 + 8 * fq;
#pragma unroll
        for (int ai = 0; ai < 2; ++ai)
#pragma unroll
            for (int m = 0; m < 4; ++m) {
                const int row = u.pm * BM + ai * HALF + wr * 64 + m * 16 + fr;
#pragma unroll
                for (int bj = 0; bj < 2; ++bj) {
                    const f32x4 v0 = acc[ai][bj][m][0] * cs, v1 = acc[ai][bj][m][1] * cs; u32x2 w; w.x = pk4_fp8(v0[0], v0[1], v0[2], v0[3]); w.y = pk4_fp8(v1[0], v1[1], v1[2], v1[3]);
                    *(u32x2*)(O + (size_t)row * 1024 + colb + bj * HALF) = w;
                }
            }
    }
};
template <int ACT> struct EpiRowBf16 {
    static constexpr bool PERM = true, MIDK = false; static constexpr int MID1 = -1, MID2 = -1;
    bf16_t* O; int ldc; const float* rs; float cs;
    __device__ __forceinline__ void operator()(const Acc& acc, const Unit& u, int wr, int wc, int fr, int fq) const {
        const int colb = u.pn * BM + wc * 32 + 8 * fq;
        float rv[2][4];
#pragma unroll
        for (int ai = 0; ai < 2; ++ai)
#pragma unroll
            for (int m = 0; m < 4; ++m) rv[ai][m] = rs ? rs[u.pm * BM + ai * HALF + wr * 64 + m * 16 + fr] : 1.f;
#pragma unroll
        for (int ai = 0; ai < 2; ++ai)
#pragma unroll
            for (int m = 0; m < 4; ++m) {
                const int row = u.pm * BM + ai * HALF + wr * 64 + m * 16 + fr; const float r = rv[ai][m];
#pragma unroll
                for (int bj = 0; bj < 2; ++bj) {
                    f32x4 v0 = acc[ai][bj][m][0] * (r * cs), v1 = acc[ai][bj][m][1] * (r * cs);
                    if (ACT == 1) {
#pragma unroll
                        for (int j = 0; j < 4; ++j) { v0[j] = fsigmoid(v0[j]); v1[j] = fsigmoid(v1[j]); } }
                    *(u32x4*)(O + (size_t)row * ldc + colb + bj * HALF) = pack8(v0, v1);
                }
            }
    }
};
struct EpiGatesNative {
    static constexpr bool PERM = true, MIDK = false; static constexpr int MID1 = -1, MID2 = -1;
    unsigned char* G; const float* rs;
    __device__ __forceinline__ void operator()(const Acc& acc, const Unit& u, int wr, int wc, int fr, int fq) const {
        float rv[2][4];
#pragma unroll
        for (int ai = 0; ai < 2; ++ai)
#pragma unroll
            for (int m = 0; m < 4; ++m) rv[ai][m] = rs[u.pm * BM + ai * HALF + wr * 64 + m * 16 + fr];
        unsigned char* gt = G + (size_t)((u.pm * 12 + u.pn) * 8 + wr * 4 + wc) * 8192 + (fq * 16 + fr) * 16;
#pragma unroll
        for (int ai = 0; ai < 2; ++ai)
#pragma unroll
            for (int m = 0; m < 4; ++m) { u32x4 o;
#pragma unroll
                for (int bj = 0; bj < 2; ++bj)
#pragma unroll
                    for (int n = 0; n < 2; ++n) { const f32x4 v = acc[ai][bj][m][n] * rv[ai][m]; unsigned w = 0;
#pragma unroll
                        for (int j = 0; j < 4; ++j) w = __builtin_amdgcn_cvt_pk_u8_f32(fmaxf(255.f * fsigmoid(v[j]), 1.f), j, w);
                        o[bj * 2 + n] = w; }
                *(u32x4*)(gt + (ai * 4 + m) * 1024) = o; }
    }
};
struct EpiMerge {
    static constexpr bool PERM = true, MIDK = true; static constexpr int MID1 = 8, MID2 = 16;
    const unsigned char* gates; bf16_t* O;
    __device__ __forceinline__ void mid(Acc& acc, const Unit& u, int t, int wr, int wc, int fr, int fq) const {
        const int i = (t == MID1) ? 0 : 1;
        const unsigned char* gp0 = gates + (size_t)((u.pm * 12 + i * 4 + u.pn) * 8 + wr * 4 + wc) * 8192 + (fq * 16 + fr) * 16;
        u32x4 av[8], bv[8];
#pragma unroll
        for (int g = 0; g < 8; ++g) { av[g] = *(const u32x4*)(gp0 + g * 1024); bv[g] = *(const u32x4*)(gp0 + g * 1024 + (size_t)4 * 8 * 8192); }
        __builtin_amdgcn_sched_barrier(0);
#pragma unroll
        for (int ai = 0; ai < 2; ++ai)
#pragma unroll
            for (int m = 0; m < 4; ++m) { const u32x4 a = av[ai * 4 + m], b = bv[ai * 4 + m];
#pragma unroll
                for (int bj = 0; bj < 2; ++bj)
#pragma unroll
                    for (int n = 0; n < 2; ++n)
#pragma unroll
                        for (int e = 0; e < 4; ++e) acc[ai][bj][m][n][e] *= (float)((a[bj * 2 + n] >> (8 * e)) & 255u) * __builtin_amdgcn_rcpf((float)((b[bj * 2 + n] >> (8 * e)) & 255u));
            }
    }
    __device__ __forceinline__ void operator()(const Acc& acc, const Unit& u, int wr, int wc, int fr, int fq) const {
        const int colb = u.pn * BM + wc * 32 + 8 * fq;
#pragma unroll
        for (int ai = 0; ai < 2; ++ai) {
            u32x4 av[4];
#pragma unroll
            for (int m = 0; m < 4; ++m) av[m] = *(const u32x4*)(gates + (size_t)((u.pm * 12 + 8 + u.pn) * 8 + wr * 4 + wc) * 8192 + (ai * 4 + m) * 1024 + (fq * 16 + fr) * 16);
            __builtin_amdgcn_sched_barrier(0);
#pragma unroll
            for (int m = 0; m < 4; ++m) {
                const int row = u.pm * BM + ai * HALF + wr * 64 + m * 16 + fr; const u32x4 a = av[m];
#pragma unroll
                for (int bj = 0; bj < 2; ++bj) {
                    f32x4 v0 = acc[ai][bj][m][0], v1 = acc[ai][bj][m][1];
#pragma unroll
                    for (int e = 0; e < 4; ++e) { v0[e] *= (float)((a[bj * 2] >> (8 * e)) & 255u) * (1.f / 255.f); v1[e] *= (float)((a[bj * 2 + 1] >> (8 * e)) & 255u) * (1.f / 255.f); }
                    *(u32x4*)(O + (size_t)row * 1024 + colb + bj * HALF) = pack8(v0, v1);
                }
            }
        }
    }
};
struct EpiOut {
    static constexpr bool PERM = true, MIDK = false; static constexpr int MID1 = -1, MID2 = -1;
    bf16_t* xb; unsigned char* xb8;
    __device__ __forceinline__ void operator()(const Acc& acc, const Unit& u, int wr, int wc, int fr, int fq) const {
        const int colb = u.pn * BM + wc * 32 + 8 * fq;
#pragma unroll
        for (int ai = 0; ai < 2; ++ai) {
            u32x4 xo[4][2];
#pragma unroll
            for (int m = 0; m < 4; ++m)
#pragma unroll
                for (int bj = 0; bj < 2; ++bj) xo[m][bj] = *(const u32x4*)(xb + (size_t)(u.pm * BM + ai * HALF + wr * 64 + m * 16 + fr) * D + colb + bj * HALF);
            __builtin_amdgcn_sched_barrier(0);
#pragma unroll
            for (int m = 0; m < 4; ++m)
#pragma unroll
                for (int bj = 0; bj < 2; ++bj) {
                    const size_t o = (size_t)(u.pm * BM + ai * HALF + wr * 64 + m * 16 + fr) * D + colb + bj * HALF; const u32x4 b = xo[m][bj];
                    const f32x4 v0 = (f32x4){__uint_as_float(b.x << 16), __uint_as_float(b.x & 0xffff0000u), __uint_as_float(b.y << 16), __uint_as_float(b.y & 0xffff0000u)} + acc[ai][bj][m][0];
                    const f32x4 v1 = (f32x4){__uint_as_float(b.z << 16), __uint_as_float(b.z & 0xffff0000u), __uint_as_float(b.w << 16), __uint_as_float(b.w & 0xffff0000u)} + acc[ai][bj][m][1];
                    *(u32x4*)(xb + o) = pack8(v0, v1);
                    u32x2 w8; w8.x = pk4_fp8(v0[0], v0[1], v0[2], v0[3]); w8.y = pk4_fp8(v1[0], v1[1], v1[2], v1[3]); *(u32x2*)(xb8 + o) = w8;
                }
        }
    }
};

struct EpiGateUp {
    static constexpr bool PERM = true, MIDK = false; static constexpr int MID1 = -1, MID2 = -1;
    unsigned char* act; const float* rowrs; const float* rowwt;
    __device__ __forceinline__ void operator()(const Acc& acc, const Unit& u, int wr, int wc, int fr, int fq) const {
        const int colb = u.pn * 128 + wc * 16 + 4 * fq;
        float rv[2][4], wv[2][4];
#pragma unroll
        for (int ai = 0; ai < 2; ++ai)
#pragma unroll
            for (int m = 0; m < 4; ++m) { const int row = u.pm * BM + ai * HALF + wr * 64 + m * 16 + fr; rv[ai][m] = rowrs[row]; wv[ai][m] = rowwt[row]; }
#pragma unroll
        for (int ai = 0; ai < 2; ++ai)
#pragma unroll
            for (int m = 0; m < 4; ++m) {
                const int row = u.pm * BM + ai * HALF + wr * 64 + m * 16 + fr; const float r = rv[ai][m] * (1.f / W8_SCALE), w = wv[ai][m] * ACT8_SCALE;
#pragma unroll
                for (int bj = 0; bj < 2; ++bj) {
                    const f32x4 gt = acc[ai][bj][m][0] * r, up = acc[ai][bj][m][1] * r; f32x4 a;
#pragma unroll
                    for (int j = 0; j < 4; ++j) a[j] = fsilu(gt[j]) * up[j] * w;
                    *(unsigned*)(act + (size_t)row * DE + colb + bj * 64) = pk4_fp8(a[0], a[1], a[2], a[3]);
                }
            }
    }
};
}

constexpr int LDS_BYTES = 147456;
constexpr int NTHREADS = 512;

__device__ __forceinline__ void setup_phase(const Params& p, int b0, int nb) {
    unsigned char* ws = p.ws; const int tid = threadIdx.x;
    float* lam = (float*)(ws + WS_LAM); float* lbs = (float*)(ws + WS_LBS); float* wrt = (float*)(ws + WS_WRT);
    if (b0 == 0) {
        if (tid < 128) {
            const int l = tid >> 6, lane = tid & 63; const float* lp = p.in[4] + l * 256;
            const float a = wave_sum(lp[lane] * lp[64 + lane]), b = wave_sum(lp[128 + lane] * lp[192 + lane]);
            const float lam_init = 0.8f - 0.6f * expf(-0.3f * (float)l);
            if (lane == 0) lam[l] = expf(a) - expf(b) + lam_init;
        }
        { const int i = tid; const float v0 = p.in[6][i], v1 = p.in[6][512 + i]; const float m = fmaxf(v0, v1); const float e0 = expf(v0 - m), e1 = expf(v1 - m);
            lbs[i] = 0.f; lbs[512 + i] = e1 / (e0 + e1); }
    }
    for (int i = b0 * 512 + tid; i < 2 * 1024 * 16; i += nb * 512) { const int l = i >> 14, ii = i & 3, e = (i >> 2) & 15, qd = (i >> 6) & 3, sidx = (i >> 8) & 63; const int k = 16 * sidx + 4 * qd + ii; wrt[i] = p.in[12][l * 1024 + k] * p.in[13][k * 16 + e]; }
}

__device__ __forceinline__ void convert_tile(const float* src, int ldsrc, const float* gain, bf16_t* dst, int Kdst, int k_off, int mode, int kt, int ntile, LAS float* tile) {
    int tid = threadIdx.x; asm volatile("" : "+v"(tid));
    { const int n = tid & 255, k0 = tid >> 8; float v[32];
      const float* sp = src + (size_t)(kt * 64 + k0) * ldsrc + ntile * 256 + n;
#pragma unroll
      for (int j = 0; j < 32; ++j) v[j] = sp[(size_t)(2 * j) * ldsrc];
      __builtin_amdgcn_sched_barrier(0);
#pragma unroll
      for (int j = 0; j < 32; ++j) { const int k = k0 + 2 * j; const float gk = gain ? gain[kt * 64 + k] : 1.f; tile[k * 257 + n] = v[j] * gk; } }
    __syncthreads();
    { const int c = tid & 7;
#pragma unroll
      for (int i = 0; i < 4; ++i) { const int n = (tid >> 3) + 64 * i; const LAS float* sl = tile + (8 * c) * 257 + n;
          u32x4 o; o.x = pk2(sl[0], sl[257]); o.y = pk2(sl[514], sl[771]); o.z = pk2(sl[1028], sl[1285]); o.w = pk2(sl[1542], sl[1799]);
          const int ng = ntile * 256 + n; const int row = mode == 0 ? ng : (8 * (ng >> 2) + (ng & 3) + (mode == 2 ? 4 : 0));
          *(u32x4*)(dst + (size_t)row * Kdst + k_off + kt * 64 + 8 * c) = o; } }
    __syncthreads();
}
__device__ __forceinline__ void convert_tile8(const float* src, int ldsrc, const float* gain, unsigned char* dst, int Kdst, int mode, int kt, int ntile, LAS float* tile) {
    int tid = threadIdx.x; asm volatile("" : "+v"(tid));
    { const int n = tid & 255, k0 = tid >> 8; float v[32];
      const float* sp = src + (size_t)(kt * 64 + k0) * ldsrc + ntile * 256 + n;
#pragma unroll
      for (int j = 0; j < 32; ++j) v[j] = sp[(size_t)(2 * j) * ldsrc];
      __builtin_amdgcn_sched_barrier(0);
#pragma unroll
      for (int j = 0; j < 32; ++j) { const int k = k0 + 2 * j; const float gk = (gain ? gain[kt * 64 + k] : 1.f) * W8_SCALE; tile[k * 257 + n] = v[j] * gk; } }
    __syncthreads();
    { const int c = tid & 3;
#pragma unroll
      for (int i = 0; i < 2; ++i) { const int n = (tid >> 2) + 128 * i; const LAS float* sl = tile + (16 * c) * 257 + n;
          u32x4 o; o.x = pk4_fp8(sl[0], sl[257], sl[514], sl[771]); o.y = pk4_fp8(sl[1028], sl[1285], sl[1542], sl[1799]); o.z = pk4_fp8(sl[2056], sl[2313], sl[2570], sl[2827]); o.w = pk4_fp8(sl[3084], sl[3341], sl[3598], sl[3855]);
          const int ng = ntile * 256 + n; const int row = mode == 0 ? ng : (8 * (ng >> 2) + (ng & 3) + (mode == 2 ? 4 : 0));
          *(u32x4*)(dst + (size_t)row * Kdst + kt * 64 + 16 * c) = o; } }
    __syncthreads();
}
__device__ __forceinline__ void convert_tile_i8(const float* src, int ldsrc, const float* gain, const unsigned* wmax, float* wsc, unsigned char* dst, int kt, int ntile, LAS float* tile) {
    int tid = threadIdx.x; asm volatile("" : "+v"(tid));
    { const int n = tid & 255, k0 = tid >> 8; float v[32];
      const float* sp = src + (size_t)(kt * 64 + k0) * ldsrc + ntile * 256 + n;
#pragma unroll
      for (int j = 0; j < 32; ++j) v[j] = sp[(size_t)(2 * j) * ldsrc];
      const float am = fmaxf(__uint_as_float(wmax[ntile * 256 + n]), 1e-30f), inv = 127.f / am;
      if (kt == 0 && k0 == 0) wsc[ntile * 256 + n] = am * (1.f / 127.f);
      __builtin_amdgcn_sched_barrier(0);
#pragma unroll
      for (int j = 0; j < 32; ++j) { const int k = k0 + 2 * j; const float gk = gain[kt * 64 + k]; tile[k * 257 + n] = (v[j] * gk) * inv; } }
    __syncthreads();
    { const int c = tid & 3;
#pragma unroll
      for (int i = 0; i < 2; ++i) { const int n = (tid >> 2) + 128 * i; const LAS float* sl = tile + (16 * c) * 257 + n;
          u32x4 o; o.x = pk4_i8(sl[0], sl[257], sl[514], sl[771]); o.y = pk4_i8(sl[1028], sl[1285], sl[1542], sl[1799]); o.z = pk4_i8(sl[2056], sl[2313], sl[2570], sl[2827]); o.w = pk4_i8(sl[3084], sl[3341], sl[3598], sl[3855]);
          *(u32x4*)(dst + (size_t)(ntile * 256 + n) * 1024 + kt * 64 + 16 * c) = o; } }
    __syncthreads();
}
__device__ __forceinline__ void wmax_phase(const Params& p, int b0, int nb) {
    int tid = threadIdx.x; asm volatile("" : "+v"(tid));
    for (int it = b0; it < 224; it += nb) {
        const int l = it / 112, r = it % 112, ntile = r >> 2, kg = r & 3, n = tid & 255, k0 = tid >> 8; float am = 0.f;
#pragma unroll 1
        for (int kk = 0; kk < 4; ++kk) { const int kt = kg * 4 + kk; float v[32];
            const float* sp = p.in[3] + (size_t)l * D * IN_TOTAL + (size_t)(kt * 64 + k0) * IN_TOTAL + ntile * 256 + n; const float* gain = p.in[2] + l * D + kt * 64 + k0;
#pragma unroll
            for (int j = 0; j < 32; ++j) v[j] = sp[(size_t)(2 * j) * IN_TOTAL];
            __builtin_amdgcn_sched_barrier(0);
#pragma unroll
            for (int j = 0; j < 32; ++j) am = fmaxf(am, fabsf(v[j] * gain[2 * j])); }
        atomicMax((unsigned*)(p.ws + WS_WMAX) + l * IN_TOTAL + ntile * 256 + n, __float_as_uint(am));
    }
}
constexpr int CT_IN = 16 * 28, CT_MEM = 64, CT_BR = 96, CT_OUT = 64, CT_G = 512, CT_U = 512, CT_D = 512;
constexpr int CT_LAYER = CT_IN + CT_MEM + CT_BR + CT_OUT + CT_G + CT_U + CT_D;
__device__ __forceinline__ void convert_mem_phase(const Params& p, LAS float* tile, int b0, int nb) {
    unsigned char* ws = p.ws;
    for (int m = b0; m < 2 * CT_MEM; m += nb) { const int l = m / CT_MEM, r = m % CT_MEM;
        convert_tile(p.in[9] + (size_t)l * D * D, D, p.in[8] + l * D, (bf16_t*)(ws + WS_WMIX + (size_t)l * WMIX_LAYER + WMIX_MEM), D, 0, 0, r / 4, r % 4, tile); }
}
__device__ __forceinline__ void convert_phase(const Params& p, LAS float* tile, int i0, int istride, int hi) {
    unsigned char* ws = p.ws;
    for (int idx = i0; idx < hi; idx += istride) {
        const int l = idx / CT_LAYER; int r = idx % CT_LAYER;
        bf16_t* wmix = (bf16_t*)(ws + WS_WMIX + (size_t)l * WMIX_LAYER); unsigned char* wmoe = ws + WS_WMOE + (size_t)l * WMOE_LAYER;
        if (r < CT_IN) { convert_tile_i8(p.in[3] + (size_t)l * D * IN_TOTAL, IN_TOTAL, p.in[2] + l * D, (const unsigned*)(ws + WS_WMAX) + l * IN_TOTAL, (float*)(ws + WS_WSC) + l * IN_TOTAL, (unsigned char*)wmix, r / 28, r % 28, tile); continue; } r -= CT_IN;
        if (r < CT_MEM) continue; r -= CT_MEM;
        if (r < CT_BR) { const int i = r / 32, rr = r % 32; convert_tile(p.in[10] + (size_t)(l * 3 + i) * 512 * D, D, nullptr, (bf16_t*)((unsigned char*)wmix + WMIX_BR), 1536, i * 512, 0, rr / 4, rr % 4, tile); continue; } r -= CT_BR;
        if (r < CT_OUT) { convert_tile(p.in[11] + (size_t)l * D * D, D, nullptr, (bf16_t*)((unsigned char*)wmix + WMIX_OUT), D, 0, 0, r / 4, r % 4, tile); continue; } r -= CT_OUT;
        if (r < CT_G) { const int e = r / 32, rr = r % 32; convert_tile8(p.in[15] + (size_t)(l * NE + e) * D * DE, DE, p.in[12] + l * D, wmoe + (size_t)e * 1024 * 1024, D, 1, rr / 2, rr % 2, tile); continue; } r -= CT_G;
        if (r < CT_U) { const int e = r / 32, rr = r % 32; convert_tile8(p.in[16] + (size_t)(l * NE + e) * D * DE, DE, p.in[12] + l * D, wmoe + (size_t)e * 1024 * 1024, D, 2, rr / 2, rr % 2, tile); continue; } r -= CT_U;
        { const int e = r / 32, rr = r % 32; convert_tile8(p.in[17] + (size_t)(l * NE + e) * DE * D, D, nullptr, wmoe + WMOE_D + (size_t)e * 1024 * 512, DE, 0, rr / 4, rr % 4, tile); }
    }
}

__device__ __forceinline__ void prep_row(const float* xrow, bf16_t* orow, float* rs_out, int lane, unsigned char* qrow = nullptr) {
    const f32x4* xr = (const f32x4*)xrow + lane; f32x4 v[4]; float s = 0.f;
#pragma unroll
    for (int j = 0; j < 4; ++j) { v[j] = xr[64 * j]; s += (v[j].x * v[j].x + v[j].y * v[j].y) + (v[j].z * v[j].z + v[j].w * v[j].w); }
    s = wave_sum(s);
    float rsv = 1.0f / sqrtf(s * (1.f / D) + EPS);
    u32x2* o = (u32x2*)orow + lane;
#pragma unroll
    for (int j = 0; j < 4; ++j) { u32x2 w; w.x = pk2(v[j].x, v[j].y); w.y = pk2(v[j].z, v[j].w); o[64 * j] = w; }
    if (qrow) { float am = 0.f;
#pragma unroll
        for (int j = 0; j < 4; ++j) am = fmaxf(am, fmaxf(fmaxf(fabsf(v[j].x), fabsf(v[j].y)), fmaxf(fabsf(v[j].z), fabsf(v[j].w))));
        am = fmaxf(wave_max(am), 1e-30f); const float inv = 127.f / am; rsv *= am * (1.f / 127.f);
        unsigned* q = (unsigned*)qrow + lane;
#pragma unroll
        for (int j = 0; j < 4; ++j) q[64 * j] = pk4_i8(v[j].x * inv, v[j].y * inv, v[j].z * inv, v[j].w * inv); }
    if (lane == 0) *rs_out = rsv;
}
__device__ __forceinline__ void prep_phase(const Params& p, int gw, int ngw, int lane) {
    unsigned char* ws = p.ws;
    for (int r = gw; r < NTOK + NMEM; r += ngw) {
        if (r < NTOK) prep_row(p.in[0] + (size_t)r * D, (bf16_t*)(ws + WS_XB) + (size_t)r * D, (float*)(ws + WS_RS) + r, lane, ws + WS_XB8 + (size_t)r * D);
        else { const int m = r - NTOK; prep_row(p.in[1] + (size_t)m * D, (bf16_t*)(ws + WS_MEMB) + (size_t)m * D, (float*)(ws + WS_RSMEM) + m, lane); }
    }
}

__device__ __forceinline__ void phase_memkv(const Params& p, LAS unsigned char* lds, int l, int c, int G) {
    unsigned char* ws = p.ws;
    pg8::Gemm g{(const bf16_t*)(ws + WS_MEMB), (const bf16_t*)(ws + WS_WMIX + (size_t)l * WMIX_LAYER + WMIX_MEM), D};
    pg8::StaticOrder S; S.init(NMEM, D, G, c);
    pg8::EpiRowBf16<0> E{(bf16_t*)(ws + WS_MKV) + (size_t)l * NMEM * D, D, (const float*)(ws + WS_RSMEM), 1.f};
    pg8::gemm_phase<pg8::EpiRowBf16<0>, pg8::StaticOrder, true>(lds, g, S, E);
}
__device__ __forceinline__ void phase_mix(const Params& p, LAS unsigned char* lds, int l, int half) {
    unsigned char* ws = p.ws;
    pg8::Gemm g{(const bf16_t*)(ws + WS_XB8) + (size_t)half * HT * (D / 2), (const bf16_t*)(ws + WS_WMIX + (size_t)l * WMIX_LAYER), D / 2, (const float*)(ws + WS_WSC) + l * IN_TOTAL};
    pg8::StaticOrder S; S.init(HT, MIXW, gridDim.x, blockIdx.x);
    pg8::EpiMix E{(bf16_t*)(ws + WS_BIG + BG_PB), (_Float16*)(ws + WS_BIG + BG_LOGF), (const float*)(ws + WS_RS) + half * HT, (const float*)(ws + WS_LBS) + l * 512, 0.125f * LOG2E, 0.08838834764831845f * LOG2E, (unsigned*)(ws + WS_KM2) + (size_t)(l * 2 + half) * 4096};
    pg8::gemm_phase<pg8::EpiMix, pg8::StaticOrder, true, 2>(lds, g, S, E);
}
__device__ __forceinline__ void phase_gates(const Params& p, LAS unsigned char* lds, int l, int half) {
    unsigned char* ws = p.ws;
    pg8::Gemm g{(const bf16_t*)(ws + WS_XB8) + (size_t)half * HT * (D / 2), (const bf16_t*)(ws + WS_WMIX + (size_t)l * WMIX_LAYER) + (size_t)MIXW * (D / 2), D / 2, (const float*)(ws + WS_WSC) + l * IN_TOTAL + MIXW};
    pg8::GatesOfMerge S; S.init(HT, D, gridDim.x, blockIdx.x);
    pg8::EpiGatesNative E{ws + WS_BIG + BG_GATES, (const float*)(ws + WS_RS) + half * HT};
    pg8::gemm_phase<pg8::EpiGatesNative, pg8::GatesOfMerge, true, 2>(lds, g, S, E);
}
__device__ __forceinline__ void phase_merge(const Params& p, LAS unsigned char* lds, int l, int half) {
    unsigned char* ws = p.ws;
    pg8::Gemm g{(const bf16_t*)(ws + WS_BIG + BG_YCAT), (const bf16_t*)(ws + WS_WMIX + (size_t)l * WMIX_LAYER + WMIX_BR), 1536};
    pg8::StaticOrder S; S.init(HT, D, gridDim.x, blockIdx.x);
    pg8::EpiMerge E{ws + WS_BIG + BG_GATES, (bf16_t*)(ws + WS_BIG + BG_MERGED) + (size_t)half * HT * D};
    pg8::gemm_phase<pg8::EpiMerge, pg8::StaticOrder, true>(lds, g, S, E);
}
__device__ __forceinline__ void phase_out(const Params& p, LAS unsigned char* lds, int l) {
    unsigned char* ws = p.ws;
    pg8::Gemm g{(const bf16_t*)(ws + WS_BIG + BG_MERGED), (const bf16_t*)(ws + WS_WMIX + (size_t)l * WMIX_LAYER + WMIX_OUT), D};
    pg8::StaticOrder S; S.init(NTOK, D, gridDim.x, blockIdx.x);
    pg8::EpiOut E{(bf16_t*)(ws + WS_XB), ws + WS_XB8};
    pg8::gemm_phase<pg8::EpiOut, pg8::StaticOrder, true>(lds, g, S, E);
}
__device__ __forceinline__ void phase_gateup(const Params& p, LAS unsigned char* lds, int l) {
    unsigned char* ws = p.ws;
    const int ntiles = *(const int*)(ws + WS_NTILES);
    pg8::Gemm g{(const bf16_t*)(ws + WS_XB8), (const bf16_t*)(ws + WS_WMOE + (size_t)l * WMOE_LAYER), D / 2};
    pg8::MoeOrder<true> S; S.init(ntiles * 256, 1024, gridDim.x, blockIdx.x); S.tile_exp = (const int*)(ws + WS_TILEEXP); S.rowtok = (const int*)(ws + WS_ROWTOK); S.estride = (size_t)1024 * 1024;
    pg8::EpiGateUp E{ws + WS_BIG + BG_ACT, (const float*)(ws + WS_ROWRS), (const float*)(ws + WS_ROWWT)};
    pg8::gemm_phase<pg8::EpiGateUp, pg8::MoeOrder<true>, true, true>(lds, g, S, E);
}
__device__ __forceinline__ void phase_down(const Params& p, LAS unsigned char* lds, int l) {
    unsigned char* ws = p.ws;
    const int ntiles = *(const int*)(ws + WS_NTILES);
    pg8::Gemm g{(const bf16_t*)(ws + WS_BIG + BG_ACT), (const bf16_t*)(ws + WS_WMOE + (size_t)l * WMOE_LAYER + WMOE_D), DE / 2};
    pg8::MoeOrder<false> S; S.init(ntiles * 256, 1024, gridDim.x, blockIdx.x); S.tile_exp = (const int*)(ws + WS_TILEEXP); S.rowtok = nullptr; S.estride = (size_t)1024 * 512;
    pg8::EpiRowFp8 E{ws + WS_BIG + BG_YSLOT, YS8_SCALE / (W8_SCALE * ACT8_SCALE)};
    pg8::gemm_phase<pg8::EpiRowFp8, pg8::MoeOrder<false>, true, true>(lds, g, S, E);
}

typedef short s16x4 __attribute__((ext_vector_type(4)));
constexpr int KSTR = 272, VSTR = 288;
constexpr int ATT_KBUF = 16384, ATT_STAGE = 32768;
template <bool DIFF>
__device__ __forceinline__ void attn_unit(LAS unsigned char* lds, const bf16_t* Q, int q_ld, const bf16_t* K, int k_ld, const bf16_t* V, int v_ld, int nkt, int i0,
                                          float slope2, float lam, float oscale, const float* sub_g, bf16_t* Y, int y_ld, const unsigned* kmaxp) {
    constexpr int KS = DIFF ? 2 : 4;
    int tid = threadIdx.x; asm volatile("" : "+v"(tid));
    const int wid = __builtin_amdgcn_readfirstlane(tid >> 6), lane = tid & 63, fr = lane & 15, quad = lane >> 4;
    const int map = DIFF ? (wid >> 2) : 0, wq = DIFF ? (wid & 3) : wid, kcol0 = DIFF ? map * 64 : 0;
    const int iw = i0 + 32 * wq;
    const int dr = lane >> 4; const unsigned dlog = (unsigned)((lane & 15) ^ ((dr << 2) | (wid & 3)));
#define ATT_DMA(t, b) do { _Pragma("unroll") for (int _i = 0; _i < 2; ++_i) { const size_t r_ = (size_t)((t) * 64 + 4 * (wid + 8 * _i) + dr); \
        __builtin_amdgcn_global_load_lds((const unsigned*)(K + r_ * k_ld + dlog * 8), (LAS unsigned*)(lds + (b) * ATT_STAGE + (wid + 8 * _i) * 1024), 16, 0, 0); \
        __builtin_amdgcn_global_load_lds((const unsigned*)(V + r_ * v_ld + dlog * 8), (LAS unsigned*)(lds + (b) * ATT_STAGE + ATT_KBUF + (wid + 8 * _i) * 1024), 16, 0, 0); } } while (0)
    ATT_DMA(nkt - 1, 0);
    bf16x8 qf[2][KS];
#pragma unroll
    for (int qb = 0; qb < 2; ++qb)
#pragma unroll
        for (int ks = 0; ks < KS; ++ks) qf[qb][ks] = *(const bf16x8*)(Q + (size_t)(32 * wq + 16 * qb + fr) * q_ld + kcol0 + ks * 32 + quad * 8);
    u32x2 kk2 = {0u, 0u}; if (DIFF && lane < nkt) kk2 = *(const u32x2*)(kmaxp + (map * 64 + lane) * 2);
    f32x4 O[8][2];
#pragma unroll
    for (int db = 0; db < 8; ++db) { O[db][0] = (f32x4){0.f, 0.f, 0.f, 0.f}; O[db][1] = (f32x4){0.f, 0.f, 0.f, 0.f}; }
    float mrow[2] = {0.f, 0.f};
    f32x4 Lacc[2] = {(f32x4){0.f, 0.f, 0.f, 0.f}, (f32x4){0.f, 0.f, 0.f, 0.f}};
    bool noshift = false;
    float qmax = 0.f, kpre = 0.f, mmin = -INFINITY; bool wdone = false; int nact = 0;
    LAS int* dflag = (LAS int*)(lds + 2 * ATT_STAGE);
    if (DIFF) {
        float qs = 0.f;
#pragma unroll
        for (int qb = 0; qb < 2; ++qb) { float a = 0.f;
#pragma unroll
            for (int ks = 0; ks < KS; ++ks)
#pragma unroll
                for (int e = 0; e < 8; ++e) { const float v = bf2f((bf16_t)qf[qb][ks][e]); a += v * v; }
            a += __shfl_xor(a, 16); a += __shfl_xor(a, 32); qs = fmaxf(qs, a); }
#pragma unroll
        for (int o = 1; o < 16; o <<= 1) qs = fmaxf(qs, __shfl_xor(qs, o));
        qmax = __builtin_amdgcn_readfirstlane(sqrtf(qs));
        float v = 0.f; if (lane < nkt) v = sqrtf(__uint_as_float(kk2.x) + __uint_as_float(kk2.y)) * 1.0001f;
#pragma unroll
        for (int o = 1; o < 64; o <<= 1) { const float t_ = __shfl_up(v, o); if (lane >= o) v = fmaxf(v, t_); }
        kpre = v;
        if (tid < 16) dflag[tid] = 0;
    }
    const unsigned fk = (unsigned)(((fr & 3) << 2) | ((fr >> 2) & 3));
    unsigned pk[KS];
#pragma unroll
    for (int ks = 0; ks < KS; ++ks) pk[ks] = (unsigned)(fr * 256) + ((((unsigned)(kcol0 / 8 + 4 * ks + quad)) ^ fk) << 4);
    const int vq = fr >> 2, vp = fr & 3; const unsigned fv = (unsigned)((vq << 2) | quad);
    unsigned pv[8];
#pragma unroll
    for (int db = 0; db < 8; ++db) pv[db] = (unsigned)((4 * quad + vq) * 256) + ((((unsigned)(2 * db + (vp >> 1))) ^ fv) << 4) + 8u * (unsigned)(vp & 1);
    __syncthreads();
    int buf = 0;
    for (int t = nkt - 1; t >= 0; --t) {
        if (t > 0) ATT_DMA(t - 1, buf ^ 1);
        __builtin_amdgcn_sched_barrier(0);
        const int j0 = t * 64;
        if (DIFF && !wdone && nact >= 2) {
            const float dmin = (float)(iw - (j0 + 63));
            if (dmin > 0.f && qmax * rlanef(kpre, t) - slope2 * dmin < mmin - 40.f) wdone = true;
        }
        const bool active = !DIFF || ((j0 <= iw + 31) && !wdone);
        if (DIFF && lane == 0) dflag[(t & 1) * 8 + wid] = wdone ? 1 : 0;
        if (active) {
            const LAS unsigned char* kb_ = lds + buf * ATT_STAGE; const LAS unsigned char* vb_ = kb_ + ATT_KBUF;
            float ib[2];
#pragma unroll
            for (int qb = 0; qb < 2; ++qb) ib[qb] = (DIFF ? slope2 * (float)(j0 + quad * 4 - (iw + 16 * qb + fr)) : 0.f) - mrow[qb];
            f32x4 sacc[4][2];
#pragma unroll
            for (int kb = 0; kb < 4; ++kb) { sacc[kb][0] = (f32x4){ib[0], ib[0], ib[0], ib[0]}; sacc[kb][1] = (f32x4){ib[1], ib[1], ib[1], ib[1]}; }
            { bf16x8 kfr[4][KS];
#pragma unroll
              for (int kb = 0; kb < 4; ++kb)
#pragma unroll
                  for (int ks = 0; ks < KS; ++ks) kfr[kb][ks] = *(const LAS bf16x8*)(kb_ + kb * 4096 + pk[ks]);
              __builtin_amdgcn_sched_barrier(0);
#pragma unroll
              for (int kb = 0; kb < 4; ++kb)
#pragma unroll
                  for (int ks = 0; ks < KS; ++ks) { sacc[kb][0] = __builtin_amdgcn_mfma_f32_16x16x32_bf16(kfr[kb][ks], qf[0][ks], sacc[kb][0], 0, 0, 0); sacc[kb][1] = __builtin_amdgcn_mfma_f32_16x16x32_bf16(kfr[kb][ks], qf[1][ks], sacc[kb][1], 0, 0, 0); } }
#define ATT_VF(dst, kk_) do { _Pragma("unroll") for (int db = 0; db < 8; ++db) { const LAS unsigned char* va_ = vb_ + (kk_) * 8192 + pv[db]; \
                const s16x4 v0 = __builtin_amdgcn_ds_read_tr16_b64_v4i16((LAS s16x4*)va_), v1 = __builtin_amdgcn_ds_read_tr16_b64_v4i16((LAS s16x4*)(va_ + 4096)); \
                bf16x8 vf; vf[0] = v0[0]; vf[1] = v0[1]; vf[2] = v0[2]; vf[3] = v0[3]; vf[4] = v1[0]; vf[5] = v1[1]; vf[6] = v1[2]; vf[7] = v1[3]; dst[db] = vf; } } while (0)
            bf16x8 vf0[8]; ATT_VF(vf0, 0);
            __builtin_amdgcn_sched_barrier(0);
            bf16x8 pf[2][2];
#pragma unroll
            for (int qb = 0; qb < 2; ++qb) {
                if (DIFF) {
#pragma unroll
                    for (int kb = 0; kb < 4; ++kb)
#pragma unroll
                        for (int jj = 0; jj < 4; ++jj) sacc[kb][qb][jj] = fmaf(slope2, (float)(16 * kb + jj), sacc[kb][qb][jj]);
                    if (j0 + 63 > iw + 16 * qb) { const int iq = iw + 16 * qb + fr;
#pragma unroll
                        for (int kb = 0; kb < 4; ++kb)
#pragma unroll
                            for (int jj = 0; jj < 4; ++jj) if (j0 + 16 * kb + quad * 4 + jj > iq) sacc[kb][qb][jj] = -INFINITY; }
                }
                if (!noshift) {
                    float mx = fmaxf(fmaxf(sacc[0][qb][0], sacc[0][qb][1]), fmaxf(sacc[0][qb][2], sacc[0][qb][3]));
#pragma unroll
                    for (int kb = 1; kb < 4; ++kb) mx = fmaxf(mx, fmaxf(fmaxf(sacc[kb][qb][0], sacc[kb][qb][1]), fmaxf(sacc[kb][qb][2], sacc[kb][qb][3])));
                    if (nact == 0 || __any(mx > 8.f)) {
                        mx = fmaxf(mx, __shfl_xor(mx, 16)); mx = fmaxf(mx, __shfl_xor(mx, 32));
                        const float delta = (nact == 0) ? mx : fmaxf(mx, 0.f); const float alpha = __builtin_amdgcn_exp2f(-delta);
                        mrow[qb] += delta; Lacc[qb] = Lacc[qb] * alpha;
#pragma unroll
                        for (int db = 0; db < 8; ++db) O[db][qb] = O[db][qb] * alpha;
#pragma unroll
                        for (int kb = 0; kb < 4; ++kb) sacc[kb][qb] = sacc[kb][qb] - delta;
                    }
                }
#pragma unroll
                for (int kb = 0; kb < 4; ++kb)
#pragma unroll
                    for (int jj = 0; jj < 4; ++jj) sacc[kb][qb][jj] = __builtin_amdgcn_exp2f(sacc[kb][qb][jj]);
#pragma unroll
                for (int kk = 0; kk < 2; ++kk) { u32x4 w; w.x = cvt_pk_bf16(sacc[2 * kk][qb][0], sacc[2 * kk][qb][1]); w.y = cvt_pk_bf16(sacc[2 * kk][qb][2], sacc[2 * kk][qb][3]);
                    w.z = cvt_pk_bf16(sacc[2 * kk + 1][qb][0], sacc[2 * kk + 1][qb][1]); w.w = cvt_pk_bf16(sacc[2 * kk + 1][qb][2], sacc[2 * kk + 1][qb][3]); pf[qb][kk] = __builtin_bit_cast(bf16x8, w); }
            }
            { const u32x4 o1 = (u32x4){0x3f803f80u, 0x3f803f80u, 0x3f803f80u, 0x3f803f80u}; const bf16x8 ones = __builtin_bit_cast(bf16x8, o1);
#pragma unroll
              for (int kk = 0; kk < 2; ++kk) { Lacc[0] = __builtin_amdgcn_mfma_f32_16x16x32_bf16(ones, pf[0][kk], Lacc[0], 0, 0, 0); Lacc[1] = __builtin_amdgcn_mfma_f32_16x16x32_bf16(ones, pf[1][kk], Lacc[1], 0, 0, 0); } }
            { bf16x8 vf1[8]; ATT_VF(vf1, 1);
              __builtin_amdgcn_sched_barrier(0);
#pragma unroll
              for (int db = 0; db < 8; ++db) { O[db][0] = __builtin_amdgcn_mfma_f32_16x16x32_bf16(vf0[db], pf[0][0], O[db][0], 0, 0, 0); O[db][1] = __builtin_amdgcn_mfma_f32_16x16x32_bf16(vf0[db], pf[1][0], O[db][1], 0, 0, 0); }
#pragma unroll
              for (int db = 0; db < 8; ++db) { O[db][0] = __builtin_amdgcn_mfma_f32_16x16x32_bf16(vf1[db], pf[0][1], O[db][0], 0, 0, 0); O[db][1] = __builtin_amdgcn_mfma_f32_16x16x32_bf16(vf1[db], pf[1][1], O[db][1], 0, 0, 0); } }
#undef ATT_VF
            if (DIFF && nact == 0) noshift = (qmax * rlanef(kpre, nkt - 1) < 50.f);
            if (DIFF && nact < 2) { float mm = fminf(mrow[0], mrow[1]);
#pragma unroll
                for (int o = 1; o < 16; o <<= 1) mm = fminf(mm, __shfl_xor(mm, o));
                mmin = __builtin_amdgcn_readfirstlane(mm); }
            ++nact;
        }
        __syncthreads();
        buf ^= 1;
        if (DIFF) { const LAS int* f_ = dflag + (t & 1) * 8; const u32x4 fa = *(const LAS u32x4*)f_, fb = *(const LAS u32x4*)(f_ + 4);
            if ((fa.x & fa.y & fa.z & fa.w & fb.x & fb.y & fb.z & fb.w) != 0u) break; }
    }
    if (DIFF) __syncthreads();
#undef ATT_DMA
    float inv[2];
#pragma unroll
    for (int qb = 0; qb < 2; ++qb) inv[qb] = 1.0f / Lacc[qb][0];
    if (DIFF) {
        LAS float* xch = (LAS float*)lds;
        if (map == 1) {
#pragma unroll
            for (int db = 0; db < 8; ++db)
#pragma unroll
                for (int qb = 0; qb < 2; ++qb)
#pragma unroll
                    for (int jj = 0; jj < 4; ++jj) xch[(wq * 64 + (db * 2 + qb) * 4 + jj) * 64 + lane] = O[db][qb][jj] * inv[qb] * lam;
        }
        __syncthreads();
        if (map == 0) {
            f32x4 gv[8];
#pragma unroll
            for (int db = 0; db < 8; ++db) gv[db] = *(const f32x4*)(sub_g + 16 * db + quad * 4);
#pragma unroll
            for (int qb = 0; qb < 2; ++qb) {
                float ss = 0.f;
#pragma unroll
                for (int db = 0; db < 8; ++db)
#pragma unroll
                    for (int jj = 0; jj < 4; ++jj) { const float o = O[db][qb][jj] * inv[qb] - xch[(wq * 64 + (db * 2 + qb) * 4 + jj) * 64 + lane]; O[db][qb][jj] = o; ss += o * o; }
                ss += __shfl_xor(ss, 16); ss += __shfl_xor(ss, 32);
                const float r = oscale / sqrtf(ss * (1.f / 128.f) + EPS);
                bf16_t* yr = Y + (size_t)(32 * wq + 16 * qb + fr) * y_ld + quad * 4;
#pragma unroll
                for (int db = 0; db < 8; ++db) { const f32x4 g = gv[db]; u32x2 w; w.x = cvt_pk_bf16(O[db][qb][0] * r * g[0], O[db][qb][1] * r * g[1]); w.y = cvt_pk_bf16(O[db][qb][2] * r * g[2], O[db][qb][3] * r * g[3]);
                    *(u32x2*)(yr + 16 * db) = w; }
            }
        }
        __syncthreads();
    } else {
#pragma unroll
        for (int qb = 0; qb < 2; ++qb) { bf16_t* yr = Y + (size_t)(32 * wq + 16 * qb + fr) * y_ld + quad * 4;
#pragma unroll
            for (int db = 0; db < 8; ++db) { u32x2 w; w.x = cvt_pk_bf16(O[db][qb][0] * inv[qb], O[db][qb][1] * inv[qb]); w.y = cvt_pk_bf16(O[db][qb][2] * inv[qb], O[db][qb][3] * inv[qb]); *(u32x2*)(yr + 16 * db) = w; } }
    }
}
constexpr size_t WS_QCTR = 8192;

constexpr size_t WS_BTOT = 3 * MiB + 786432;
constexpr int HL_QH = 0, HL_KH = 17408, HL_Q1 = 34816, HL_K2 = 52224, HL_VT = 70656, HL_AT = 89088, HL_SEG = 98304, HL_D = 102400, HL_ER = 136704, HL_ETR = 137216;
constexpr int ATSTR = 144;
struct HgIn { unsigned lfh[8]; unsigned q[8]; u32x4 v[2]; };
template <bool FULL>
__device__ __forceinline__ void hg_load(HgIn& in, const _Float16* lf, const bf16_t* hq, const bf16_t* hv) {
    int tid = threadIdx.x; asm volatile("" : "+v"(tid)); const int kp = tid & 63, tq = tid >> 6;
#pragma unroll
    for (int i = 0; i < 8; ++i) { in.lfh[i] = *(const unsigned*)(lf + (size_t)(8 * tq + i) * 512 + 2 * kp); if (FULL) in.q[i] = *(const unsigned*)(hq + (size_t)(8 * tq + i) * 512 + 2 * kp); }
    const int srow = tid >> 4, sc = tid & 15;
#pragma unroll
    for (int i = 0; i < 2; ++i) in.v[i] = *(const u32x4*)(hv + (size_t)(srow + 32 * i) * 512 + sc * 8);
    __builtin_amdgcn_sched_barrier(0);
}
template <bool FULL>
__device__ __forceinline__ f32x2 hg_build(LAS unsigned char* lds, const HgIn& in, f32x2 Radd) {
    int tid = threadIdx.x; asm volatile("" : "+v"(tid)); const int kp = tid & 63, tq = tid >> 6;
    f32x2 cum[8]; f32x2 c = (f32x2){0.f, 0.f};
    typedef _Float16 h16x2 __attribute__((ext_vector_type(2))); f32x2 lfv[8];
#pragma unroll
    for (int i = 0; i < 8; ++i) { const h16x2 h_ = __builtin_bit_cast(h16x2, in.lfh[i]); lfv[i] = (f32x2){(float)h_[0], (float)h_[1]}; c = c + lfv[i]; cum[i] = c; }
    LAS float* seg = (LAS float*)(lds + HL_SEG);
    *(LAS f32x2*)(seg + tq * 128 + 2 * kp) = c;
    { const int srow = tid >> 4, sc = tid & 15;
#pragma unroll
      for (int i = 0; i < 2; ++i) *(LAS u32x4*)(lds + HL_VT + (srow + 32 * i) * VSTR + sc * 16) = in.v[i]; }
    lds_barrier();
    f32x2 pre = (f32x2){0.f, 0.f}, tot = (f32x2){0.f, 0.f}, r = (f32x2){0.f, 0.f};
    f32x2 sv[8];
#pragma unroll
    for (int q = 0; q < 8; ++q) sv[q] = *(const LAS f32x2*)(seg + q * 128 + 2 * kp);
    __builtin_amdgcn_sched_barrier(0);
#pragma unroll
    for (int q = 0; q < 8; ++q) { const f32x2 v = sv[q]; tot = tot + v; if (q < 4) r = r + v; if (q < tq) pre = pre + v; }
    const f32x2 er = (f32x2){__expf(r.x), __expf(r.y)}, etr = (f32x2){__expf(tot.x - r.x + Radd.x), __expf(tot.y - r.y + Radd.y)};
#pragma unroll
    for (int i = 0; i < 8; ++i) {
        const int t = 8 * tq + i; const f32x2 b = pre + cum[i];
        const float kk0 = 1.f - __expf(lfv[i].x), kk1 = 1.f - __expf(lfv[i].y);
        const float e10 = __expf(fminf(fmaxf(b.x - r.x, -80.f), 80.f)), e11 = __expf(fminf(fmaxf(b.y - r.y, -80.f), 80.f));
        const float i10 = __builtin_amdgcn_rcpf(e10), i11 = __builtin_amdgcn_rcpf(e11);
        const float kh0 = kk0 * i10, kh1 = kk1 * i11;
        if (FULL) {
            const float q0 = __uint_as_float(in.q[i] << 16), q1 = __uint_as_float(in.q[i] & 0xffff0000u);
            *(LAS unsigned*)(lds + HL_QH + t * KSTR + kp * 4) = cvt_pk_bf16(q0 * e10, q1 * e11);
            *(LAS unsigned*)(lds + HL_KH + t * KSTR + kp * 4) = cvt_pk_bf16(kh0, kh1);
        } else {
            *(LAS unsigned*)(lds + HL_K2 + t * VSTR + kp * 4) = cvt_pk_bf16(kh0 * etr.x, kh1 * etr.y);
        }
    }
    if (FULL && tq == 1) { *(LAS f32x2*)(lds + HL_ER + kp * 8) = er; *(LAS f32x2*)(lds + HL_ETR + kp * 8) = etr; }
    if (FULL && tq == 0) *(LAS f32x2*)(lds + HL_D + kp * 8) = (f32x2){__expf(tot.x), __expf(tot.y)};
    return tot;
}
__device__ __forceinline__ bf16x8 tr_frag(const LAS unsigned char* base, int stride, int kk, int cb, int lane) {
    const int fr = lane & 15, quad = lane >> 4; const LAS unsigned char* a = base + (32 * kk + 8 * quad + (fr >> 2)) * stride + 32 * cb + 8 * (fr & 3);
    const s16x4 v0 = __builtin_amdgcn_ds_read_tr16_b64_v4i16((LAS s16x4*)a), v1 = __builtin_amdgcn_ds_read_tr16_b64_v4i16((LAS s16x4*)(a + 4 * stride));
    bf16x8 f; f[0] = v0[0]; f[1] = v0[1]; f[2] = v0[2]; f[3] = v0[3]; f[4] = v1[0]; f[5] = v1[1]; f[6] = v1[2]; f[7] = v1[3]; return f;
}
__device__ __forceinline__ void phase_hgrnA(const Params& p, LAS unsigned char* lds, int b0, int nb) {
    unsigned char* ws = p.ws; int tid = threadIdx.x; asm volatile("" : "+v"(tid)); const int wid = __builtin_amdgcn_readfirstlane(tid >> 6), lane = tid & 63;
    const bf16_t* hv = (const bf16_t*)(ws + WS_BIG + BG_PB) + (size_t)SL_HV * HT * 512; const _Float16* lf = (const _Float16*)(ws + WS_BIG + BG_LOGF);
    for (int u = b0; u < 256; u += nb) {
        const int j = u & 15, h = (u >> 4) & 3, bl = u >> 6; const size_t tok0 = (size_t)bl * SEQ + j * 256;
        f32x4 acc[8];
#pragma unroll
        for (int kb = 0; kb < 8; ++kb) acc[kb] = (f32x4){0.f, 0.f, 0.f, 0.f};
        f32x2 R = (f32x2){0.f, 0.f};
        HgIn cur; { const size_t tb = (tok0 + 64 * 3) * 512 + h * 128; hg_load<false>(cur, lf + tb, nullptr, hv + tb); }
#pragma unroll 1
        for (int c = 3; c >= 0; --c) {
            R = R + hg_build<false>(lds, cur, R);
            lds_barrier();
            if (c > 0) { const size_t tb = (tok0 + 64 * (c - 1)) * 512 + h * 128; hg_load<false>(cur, lf + tb, nullptr, hv + tb); }
            bf16x8 vf[2]; vf[0] = tr_frag(lds + HL_VT, VSTR, 0, wid, lane); vf[1] = tr_frag(lds + HL_VT, VSTR, 1, wid, lane);
#pragma unroll
            for (int kh = 0; kh < 2; ++kh) {
                bf16x8 kf[4][2];
#pragma unroll
                for (int b4 = 0; b4 < 4; ++b4) { kf[b4][0] = tr_frag(lds + HL_K2, VSTR, 0, 4 * kh + b4, lane); kf[b4][1] = tr_frag(lds + HL_K2, VSTR, 1, 4 * kh + b4, lane); }
                __builtin_amdgcn_sched_barrier(0);
#pragma unroll
                for (int kk = 0; kk < 2; ++kk)
#pragma unroll
                    for (int b4 = 0; b4 < 4; ++b4) acc[4 * kh + b4] = __builtin_amdgcn_mfma_f32_16x16x32_bf16(kf[b4][kk], vf[kk], acc[4 * kh + b4], 0, 0, 0);
            }
            lds_barrier();
        }
        float* Ln = (float*)(ws + WS_ST) + (size_t)u * 16384 + wid * 2048;
#pragma unroll
        for (int kb = 0; kb < 8; ++kb) *(f32x4*)(Ln + (kb * 64 + lane) * 4) = acc[kb];
        if (tid < 64) *(f32x2*)((float*)(ws + WS_BTOT) + u * 128 + 2 * tid) = (f32x2){__expf(R.x), __expf(R.y)};
    }
}
constexpr int HL_DTAB = 138240;
constexpr int HL_OB = 102912, OBSTR = 132;
__device__ __forceinline__ void hgrnC_unit(const Params& p, LAS unsigned char* lds, int l, int u) {
    unsigned char* ws = p.ws; int tid = threadIdx.x; asm volatile("" : "+v"(tid)); const int wid = __builtin_amdgcn_readfirstlane(tid >> 6), lane = tid & 63, fr = lane & 15, quad = lane >> 4;
    const bf16_t* hq = (const bf16_t*)(ws + WS_BIG + BG_PB) + (size_t)SL_HQ * HT * 512; const bf16_t* hv = (const bf16_t*)(ws + WS_BIG + BG_PB) + (size_t)SL_HV * HT * 512;
    const bf16_t* hgp = (const bf16_t*)(ws + WS_BIG + BG_PB) + (size_t)SL_HG * HT * 512; bf16_t* ycat = (bf16_t*)(ws + WS_BIG + BG_YCAT);
    const _Float16* lf = (const _Float16*)(ws + WS_BIG + BG_LOGF);
    const int j = u & 15, h = (u >> 4) & 3, bl = u >> 6; const size_t tok0 = (size_t)bl * SEQ + j * 256;
    HgIn cur; { const size_t tb = tok0 * 512 + h * 128; hg_load<true>(cur, lf + tb, hq + tb, hv + tb); }
    f32x4 acc[8];
#pragma unroll
    for (int kb = 0; kb < 8; ++kb) acc[kb] = (f32x4){0.f, 0.f, 0.f, 0.f};
    if (j > 0) {
        const float* Lb = (const float*)(ws + WS_ST) + (size_t)(u - j) * 16384 + wid * 2048 + lane * 4; const int jm = j - 1;
        f32x4 l0[8], l1[8], l2[8];
#define HG_LD(dst, jp_) do { const float* Ln_ = Lb + (size_t)((jp_) < jm ? (jp_) : jm) * 16384; _Pragma("unroll") for (int kb = 0; kb < 8; ++kb) dst[kb] = *(const f32x4*)(Ln_ + kb * 256); } while (0)
#define HG_FOLD(src, jp_) do { _Pragma("unroll") for (int kb = 0; kb < 8; ++kb) acc[kb] = acc[kb] * *(const LAS f32x4*)(lds + HL_DTAB + ((jp_) * 128 + 16 * kb + quad * 4) * 4) + src[kb]; } while (0)
        HG_LD(l0, 0); HG_LD(l1, 1); HG_LD(l2, 2);
        { const float* Dt = (const float*)(ws + WS_BTOT) + (u - j) * 128; for (int i = tid; i < j * 128; i += NTHREADS) ((LAS float*)(lds + HL_DTAB))[i] = Dt[i]; }
        __syncthreads();
#pragma unroll 1
        for (int jp = 0; jp < j; jp += 3) {
            HG_FOLD(l0, jp); HG_LD(l0, jp + 3);
            if (jp + 1 < j) { HG_FOLD(l1, jp + 1); HG_LD(l1, jp + 4); }
            if (jp + 2 < j) { HG_FOLD(l2, jp + 2); HG_LD(l2, jp + 5); }
        }
#undef HG_LD
#undef HG_FOLD
    }
    const float g0 = p.in[7][l * 128 + lane], g1 = p.in[7][l * 128 + 64 + lane];
#pragma unroll 1
    for (int c = 0; c < 4; ++c) {
        (void)hg_build<true>(lds, cur, (f32x2){0.f, 0.f});
        lds_barrier();
        { const int tbk = wid >> 1, sb0 = 2 * (wid & 1);
          bf16x8 qfr[4], kfr[2][4];
#pragma unroll
          for (int ks = 0; ks < 4; ++ks) { qfr[ks] = *(const LAS bf16x8*)(lds + HL_QH + (16 * tbk + fr) * KSTR + (ks * 32 + quad * 8) * 2);
#pragma unroll
              for (int e = 0; e < 2; ++e) kfr[e][ks] = *(const LAS bf16x8*)(lds + HL_KH + (16 * (sb0 + e) + fr) * KSTR + (ks * 32 + quad * 8) * 2); }
          __builtin_amdgcn_sched_barrier(0);
          f32x4 sa[2] = {(f32x4){0.f, 0.f, 0.f, 0.f}, (f32x4){0.f, 0.f, 0.f, 0.f}};
#pragma unroll
          for (int ks = 0; ks < 4; ++ks)
#pragma unroll
              for (int e = 0; e < 2; ++e) sa[e] = __builtin_amdgcn_mfma_f32_16x16x32_bf16(qfr[ks], kfr[e][ks], sa[e], 0, 0, 0);
#pragma unroll
          for (int e = 0; e < 2; ++e) { const int sbk = sb0 + e;
#pragma unroll
              for (int jj = 0; jj < 4; ++jj) { const int t = 16 * tbk + quad * 4 + jj, sidx = 16 * sbk + fr; const float v = (sidx <= t) ? sa[e][jj] : 0.f; *(LAS bf16_t*)(lds + HL_AT + t * ATSTR + sidx * 2) = (bf16_t)f2bf(v); } } }
        bf16_t ha[8], hb[8];
#pragma unroll
        for (int i = 0; i < 8; ++i) { const bf16_t* hg = hgp + (tok0 + 64 * c + wid * 8 + i) * 512 + h * 128; ha[i] = hg[lane]; hb[i] = hg[64 + lane]; }
        __builtin_amdgcn_sched_barrier(0);
        if (c < 3) { const size_t tb = (tok0 + 64 * (c + 1)) * 512 + h * 128; hg_load<true>(cur, lf + tb, hq + tb, hv + tb); }
        lds_barrier();
        bf16x8 vf[2]; vf[0] = tr_frag(lds + HL_VT, VSTR, 0, wid, lane); vf[1] = tr_frag(lds + HL_VT, VSTR, 1, wid, lane);
        bf16x8 sf[4];
        { f32x4 er[8];
#pragma unroll
          for (int kk = 0; kk < 4; ++kk) { er[2 * kk] = *(const LAS f32x4*)(lds + HL_ER + (32 * kk + quad * 4) * 4); er[2 * kk + 1] = *(const LAS f32x4*)(lds + HL_ER + (32 * kk + 16 + quad * 4) * 4); }
#pragma unroll
          for (int kk = 0; kk < 4; ++kk) { const f32x4 a0 = acc[2 * kk] * er[2 * kk], a1 = acc[2 * kk + 1] * er[2 * kk + 1];
            u32x4 w; w.x = cvt_pk_bf16(a0[0], a0[1]); w.y = cvt_pk_bf16(a0[2], a0[3]); w.z = cvt_pk_bf16(a1[0], a1[1]); w.w = cvt_pk_bf16(a1[2], a1[3]); sf[kk] = __builtin_bit_cast(bf16x8, w); } }
#pragma unroll
        for (int tp = 0; tp < 2; ++tp) {
            bf16x8 aat[2][2]; u32x4 aq[2][4];
#pragma unroll
            for (int b2 = 0; b2 < 2; ++b2) { const int tbk = 2 * tp + b2;
#pragma unroll
                for (int ks = 0; ks < 2; ++ks) aat[b2][ks] = *(const LAS bf16x8*)(lds + HL_AT + (16 * tbk + fr) * ATSTR + (ks * 32 + quad * 8) * 2);
#pragma unroll
                for (int kk = 0; kk < 4; ++kk) { const LAS unsigned char* qp = lds + HL_QH + (16 * tbk + fr) * KSTR + (32 * kk + quad * 4) * 2; const u32x2 a0 = *(const LAS u32x2*)qp, a1 = *(const LAS u32x2*)(qp + 32);
                    aq[b2][kk] = (u32x4){a0.x, a0.y, a1.x, a1.y}; } }
            __builtin_amdgcn_sched_barrier(0);
            f32x4 o[2] = {(f32x4){0.f, 0.f, 0.f, 0.f}, (f32x4){0.f, 0.f, 0.f, 0.f}};
#pragma unroll
            for (int ks = 0; ks < 2; ++ks)
#pragma unroll
                for (int b2 = 0; b2 < 2; ++b2) o[b2] = __builtin_amdgcn_mfma_f32_16x16x32_bf16(aat[b2][ks], vf[ks], o[b2], 0, 0, 0);
#pragma unroll
            for (int kk = 0; kk < 4; ++kk)
#pragma unroll
                for (int b2 = 0; b2 < 2; ++b2) o[b2] = __builtin_amdgcn_mfma_f32_16x16x32_bf16(__builtin_bit_cast(bf16x8, aq[b2][kk]), sf[kk], o[b2], 0, 0, 0);
#pragma unroll
            for (int b2 = 0; b2 < 2; ++b2)
#pragma unroll
                for (int jj = 0; jj < 4; ++jj) ((LAS float*)(lds + HL_OB))[(16 * (2 * tp + b2) + quad * 4 + jj) * OBSTR + 16 * wid + fr] = o[b2][jj];
        }
#pragma unroll
        for (int kh = 0; kh < 2; ++kh) {
            bf16x8 kf[4][2]; f32x4 dv[4], ev[4];
#pragma unroll
            for (int b4 = 0; b4 < 4; ++b4) { const int kb = 4 * kh + b4; kf[b4][0] = tr_frag(lds + HL_KH, KSTR, 0, kb, lane); kf[b4][1] = tr_frag(lds + HL_KH, KSTR, 1, kb, lane);
                dv[b4] = *(const LAS f32x4*)(lds + HL_D + (16 * kb + quad * 4) * 4); ev[b4] = *(const LAS f32x4*)(lds + HL_ETR + (16 * kb + quad * 4) * 4); }
            __builtin_amdgcn_sched_barrier(0);
            f32x4 tmp[4];
#pragma unroll
            for (int b4 = 0; b4 < 4; ++b4) tmp[b4] = (f32x4){0.f, 0.f, 0.f, 0.f};
#pragma unroll
            for (int kk = 0; kk < 2; ++kk)
#pragma unroll
                for (int b4 = 0; b4 < 4; ++b4) tmp[b4] = __builtin_amdgcn_mfma_f32_16x16x32_bf16(kf[b4][kk], vf[kk], tmp[b4], 0, 0, 0);
#pragma unroll
            for (int b4 = 0; b4 < 4; ++b4) acc[4 * kh + b4] = acc[4 * kh + b4] * dv[b4] + tmp[b4] * ev[b4];
        }
        lds_barrier();
        { float o0[8], o1[8], ss[8];
#pragma unroll
          for (int i = 0; i < 8; ++i) { const LAS float* orow = (const LAS float*)(lds + HL_OB) + (wid * 8 + i) * OBSTR; o0[i] = orow[lane]; o1[i] = orow[64 + lane]; }
          __builtin_amdgcn_sched_barrier(0);
#pragma unroll
          for (int i = 0; i < 8; ++i) ss[i] = wave_sum(o0[i] * o0[i] + o1[i] * o1[i]);
#pragma unroll
          for (int i = 0; i < 8; ++i) { const float rr = 1.0f / sqrtf(ss[i] * (1.f / 128.f) + EPS); bf16_t* y = ycat + (tok0 + 64 * c + wid * 8 + i) * 1536 + 512 + h * 128;
              y[lane] = (bf16_t)f2bf(o0[i] * rr * g0 * bf2f(ha[i])); y[64 + lane] = (bf16_t)f2bf(o1[i] * rr * g1 * bf2f(hb[i])); } }
    }
    __syncthreads();
}
__device__ __forceinline__ void phase_diff(const Params& p, LAS unsigned char* lds, int l, int half) {
    unsigned char* ws = p.ws;
    const bf16_t* qa = (const bf16_t*)(ws + WS_BIG + BG_PB) + (size_t)SL_QA * HT * 512; const bf16_t* ka = (const bf16_t*)(ws + WS_BIG + BG_PB) + (size_t)SL_KA * HT * 512;
    const bf16_t* va = (const bf16_t*)(ws + WS_BIG + BG_PB) + (size_t)SL_VA * HT * 512; bf16_t* ycat = (bf16_t*)(ws + WS_BIG + BG_YCAT);
    const float lam = ((const float*)(ws + WS_LAM))[l]; const float lam_init = 0.8f - 0.6f * __expf(-0.3f * (float)l);
    unsigned* qctr = (unsigned*)(ws + WS_QCTR) + 64 * (l * 2 + half); LAS unsigned* uslot = (LAS unsigned*)(lds + LDS_BYTES - 32);
#pragma unroll 1
    for (;;) {
        if (threadIdx.x == 0) *uslot = __hip_atomic_fetch_add(qctr, 1u, __ATOMIC_RELAXED, __HIP_MEMORY_SCOPE_AGENT);
        __syncthreads();
        int idx = (int)*uslot;
        if (idx >= 1024) break;
        if (idx >= 768) {
            const int u = idx - 768, qt = u & 15, hh = (u >> 4) & 3, bl = u >> 6; const int b = half * HB + bl;
            const bf16_t* cq = (const bf16_t*)(ws + WS_BIG + BG_PB) + (size_t)SL_CQ * HT * 512;
            const bf16_t* mkv = (const bf16_t*)(ws + WS_MKV) + (size_t)l * NMEM * D + (size_t)b * MEMLEN * D + hh * 128; const size_t t0 = (size_t)bl * SEQ + qt * 256;
            attn_unit<false>(lds, cq + t0 * 512 + hh * 128, 512, mkv, D, mkv + 512, D, MEMLEN / 64, 0, 0.f, 0.f, 0.f, nullptr, ycat + t0 * 1536 + 1024 + hh * 128, 1536, nullptr);
            continue;
        }
        if (idx >= 256 && idx < 512) { const int u_ = idx - 256; hgrnC_unit(p, lds, l, (u_ & ~15) | (15 - (u_ & 15))); continue; }
        if (idx >= 512) idx -= 256;
        const int h = 3 - (idx >> 7), rem = idx & 127, qt = 31 - (rem >> 2), bl = rem & 3; const float slope2 = exp2f(-2.0f * (float)(h + 1)) * LOG2E;
        const size_t tb = (size_t)bl * SEQ; const int i0 = qt * 128;
        attn_unit<true>(lds, qa + (tb + i0) * 512 + h * 128, 512, ka + tb * 512 + h * 128, 512, va + tb * 512 + h * 128, 512, 2 * (qt + 1), i0, slope2, lam, 1.f - lam_init, p.in[5] + l * 128,
                        ycat + (tb + i0) * 1536 + h * 128, 1536, (const unsigned*)(ws + WS_KM2) + (size_t)(l * 2 + half) * 4096 + (bl * 4 + h) * 256);
    }
}

__device__ __forceinline__ void route_phase(const Params& p, int l, LAS unsigned char* lds, int b0, int nb) {
    unsigned char* ws = p.ws; int tid = threadIdx.x; asm volatile("" : "+v"(tid)); const int lane = tid & 63, wv = tid >> 6, fr = lane & 15, quad = lane >> 4;
    const float* bias = p.in[14];
    LAS float* wtab = (LAS float*)lds; LAS int* hist = (LAS int*)(lds + 65536);
    { const f32x4* src = (const f32x4*)((const float*)(ws + WS_WRT) + l * 16384);
      f32x4 tv[8];
#pragma unroll
      for (int i = 0; i < 8; ++i) tv[i] = src[tid + 512 * i];
      __builtin_amdgcn_sched_barrier(0);
#pragma unroll
      for (int i = 0; i < 8; ++i) ((LAS f32x4*)wtab)[tid + 512 * i] = tv[i]; }
    const f32x4 bv = *(const f32x4*)(bias + quad * 4);
    __syncthreads();
    for (int ch = b0; ch < NTOK / 128; ch += nb) {
        if (tid < 16) hist[tid] = 0;
        __syncthreads();
        const int tok = ch * 128 + wv * 16 + fr; const u32x2* xr = (const u32x2*)((const bf16_t*)(ws + WS_XB) + (size_t)tok * D) + quad;
        f32x4 acc = (f32x4){0.f, 0.f, 0.f, 0.f}; float ss = 0.f;
        u32x2 xall[64];
#pragma unroll
        for (int sidx = 0; sidx < 64; ++sidx) xall[sidx] = xr[4 * sidx];
        __builtin_amdgcn_sched_barrier(0);
#pragma unroll
        for (int sidx = 0; sidx < 64; ++sidx) {
            const u32x2 xb2 = xall[sidx]; const f32x4 xv = (f32x4){__uint_as_float(xb2.x << 16), __uint_as_float(xb2.x & 0xffff0000u), __uint_as_float(xb2.y << 16), __uint_as_float(xb2.y & 0xffff0000u)}; const f32x4 wv4 = *(const LAS f32x4*)(wtab + ((sidx * 4 + quad) * 16 + fr) * 4);
            ss += (xv.x * xv.x + xv.y * xv.y) + (xv.z * xv.z + xv.w * xv.w);
            acc = __builtin_amdgcn_mfma_f32_16x16x4f32(wv4.x, xv.x, acc, 0, 0, 0); acc = __builtin_amdgcn_mfma_f32_16x16x4f32(wv4.y, xv.y, acc, 0, 0, 0);
            acc = __builtin_amdgcn_mfma_f32_16x16x4f32(wv4.z, xv.z, acc, 0, 0, 0); acc = __builtin_amdgcn_mfma_f32_16x16x4f32(wv4.w, xv.w, acc, 0, 0, 0);
        }
        ss += __shfl_xor(ss, 16); ss += __shfl_xor(ss, 32);
        const float r = 1.0f / sqrtf(ss * (1.f / D) + EPS);
        float a = -INFINITY, b = -INFINITY, sa = 0.f, sb = 0.f; int ia = 0, ib = 0;
#pragma unroll
        for (int k = 0; k < 4; ++k) { const float scv = 1.f / (1.f + expf(-acc[k] * r)); const float v = scv + bv[k]; const int e = quad * 4 + k;
            if (v > a) { b = a; ib = ia; sb = sa; a = v; ia = e; sa = scv; } else if (v > b) { b = v; ib = e; sb = scv; } }
        const float gs = a + b;
        int best = 0; float bestv = __shfl(gs, fr);
#pragma unroll
        for (int g = 1; g < 4; ++g) { const float v = __shfl(gs, fr + 16 * g); if (v > bestv) { bestv = v; best = g; } }
        if (quad == best) { const float inv = 1.f / (sa + sb); u32x4 ti4; ti4.x = (unsigned)ia; ti4.y = (unsigned)ib; ti4.z = __float_as_uint(sa * inv); ti4.w = __float_as_uint(sb * inv);
            *(u32x4*)(ws + WS_TOKINFO + (size_t)tok * 16) = ti4; ((float*)(ws + WS_RS))[tok] = r; atomicAdd((int*)&hist[ia], 1); atomicAdd((int*)&hist[ib], 1); }
        __syncthreads();
        if (tid < 16) ((int*)(ws + WS_CHUNKCNT))[ch * 16 + tid] = hist[tid];
        __syncthreads();
    }
}

__device__ __forceinline__ void lists_phase(const Params& p, LAS int* sm, int b0, int nb) {
    unsigned char* ws = p.ws; int tid = threadIdx.x; asm volatile("" : "+v"(tid));
    const int* cc = (const int*)(ws + WS_CHUNKCNT); int* rowtok = (int*)(ws + WS_ROWTOK); float* rowwt = (float*)(ws + WS_ROWWT); float* rowrs = (float*)(ws + WS_ROWRS);
    int* pos = (int*)(ws + WS_POS); const float* rs = (const float*)(ws + WS_RS);
    LAS int* part = sm;
    LAS int* tot = sm + 512;
    LAS int* start = sm + 528;
    LAS int* base = sm + 560;
    LAS int* e0s = sm + 576;
    LAS int* e1s = sm + 704;
    for (int ch = b0; ch < NTOK / 128; ch += nb) {
        { const int e = tid & 15, pt = tid >> 4; int s = 0; for (int c = pt * 8; c < pt * 8 + 8; ++c) s += cc[c * 16 + e]; part[pt * 16 + e] = s; }
        __syncthreads();
        if (tid < 16) { int s = 0; for (int pt = 0; pt < 32; ++pt) s += part[pt * 16 + tid]; tot[tid] = s; }
        __syncthreads();
        if (tid == 0) { int s = 0; for (int e = 0; e < 16; ++e) { start[e] = s; s += ((tot[e] + 255) >> 8) << 8; } start[16] = s; }
        __syncthreads();
        if (tid < 16) { int s = start[tid]; const int pf = ch >> 3; for (int pt = 0; pt < pf; ++pt) s += part[pt * 16 + tid]; for (int c = pf * 8; c < ch; ++c) s += cc[c * 16 + tid]; base[tid] = s; }
        u32x4 ti = (u32x4){0u, 0u, 0u, 0u}; int r0 = 0, r1 = 0;
        if (tid < 128) {
            ti = *(const u32x4*)(ws + WS_TOKINFO + (size_t)(ch * 128 + tid) * 16);
            const int e0 = (int)ti.x, e1 = (int)ti.y, ln = tid & 63; const unsigned long long lt = (1ull << ln) - 1ull; int c0 = 0;
#pragma unroll 1
            for (int e = 0; e < 16; ++e) { const unsigned long long bm = __ballot(e0 == e || e1 == e);
                if (e0 == e) r0 = __popcll(bm & lt); if (e1 == e) r1 = __popcll(bm & lt); if (ln == e) c0 = __popcll(bm); }
            if (tid < 16) e0s[tid] = c0;
        }
        __syncthreads();
        if (tid < 128) {
            const int tok = ch * 128 + tid;
            const int e0 = (int)ti.x, e1 = (int)ti.y;
            if (tid >= 64) { r0 += e0s[e0]; r1 += e0s[e1]; }
            const int p0 = base[e0] + r0, p1 = base[e1] + r1; const float r = rs[tok];
            rowtok[p0] = tok; rowwt[p0] = __uint_as_float(ti.z); rowrs[p0] = r; rowtok[p1] = tok; rowwt[p1] = __uint_as_float(ti.w); rowrs[p1] = r;
            pos[tok * 2] = p0; pos[tok * 2 + 1] = p1;
        }
        if (ch < 16) {
            const int e = ch, s0 = start[e] + tot[e], s1 = start[e + 1];
            for (int r = s0 + tid; r < s1; r += NTHREADS) { rowtok[r] = 0; rowwt[r] = 0.f; rowrs[r] = 0.f; }
            for (int t = (start[e] >> 8) + tid; t < (s1 >> 8); t += NTHREADS) ((int*)(ws + WS_TILEEXP))[t] = e;
            if (e == 0 && tid == 0) *(int*)(ws + WS_NTILES) = start[16] >> 8;
        }
        __syncthreads();
    }
}

struct CombRows { u32x2 xa[4]; unsigned ya[4], yb[4]; };
__device__ __forceinline__ void comb_load(CombRows& r, const unsigned char* ws, int tok, int p0, int p1, int lane) {
    const u32x2* xr = (const u32x2*)((const bf16_t*)(ws + WS_XB) + (size_t)tok * D) + lane; const unsigned char* ys = ws + WS_BIG + BG_YSLOT;
    const unsigned* y0 = (const unsigned*)(ys + (size_t)p0 * D) + lane; const unsigned* y1 = (const unsigned*)(ys + (size_t)p1 * D) + lane;
#pragma unroll
    for (int j = 0; j < 4; ++j) { r.xa[j] = xr[64 * j]; r.ya[j] = y0[64 * j]; r.yb[j] = y1[64 * j]; }
}
__device__ __forceinline__ void comb_finish(const Params& p, const CombRows& c, const f32x4 (&gfv)[4], int l, int tok, int lane) {
    unsigned char* ws = p.ws;
    f32x4 v[4]; float s = 0.f;
#pragma unroll
    for (int j = 0; j < 4; ++j) {
        const f32x2 a01 = __builtin_amdgcn_cvt_pk_f32_fp8((int)c.ya[j], false), a23 = __builtin_amdgcn_cvt_pk_f32_fp8((int)c.ya[j], true), b01 = __builtin_amdgcn_cvt_pk_f32_fp8((int)c.yb[j], false), b23 = __builtin_amdgcn_cvt_pk_f32_fp8((int)c.yb[j], true);
        constexpr float ysc = 1.f / YS8_SCALE;
        v[j].x = __uint_as_float(c.xa[j].x << 16) + (a01[0] + b01[0]) * ysc; v[j].y = __uint_as_float(c.xa[j].x & 0xffff0000u) + (a01[1] + b01[1]) * ysc;
        v[j].z = __uint_as_float(c.xa[j].y << 16) + (a23[0] + b23[0]) * ysc; v[j].w = __uint_as_float(c.xa[j].y & 0xffff0000u) + (a23[1] + b23[1]) * ysc;
        s += (v[j].x * v[j].x + v[j].y * v[j].y) + (v[j].z * v[j].z + v[j].w * v[j].w); }
    s = wave_sum(s); const float r = 1.0f / sqrtf(s * (1.f / D) + EPS);
    if (l == DEPTH - 1) {
        f32x4* orow = (f32x4*)(p.out + (size_t)tok * D) + lane;
#pragma unroll
        for (int j = 0; j < 4; ++j) orow[64 * j] = v[j] * r * gfv[j];
    } else {
        u32x2* xr = (u32x2*)((bf16_t*)(ws + WS_XB) + (size_t)tok * D) + lane;
        u32x2 w[4]; float s2 = 0.f, am = 0.f;
#pragma unroll
        for (int j = 0; j < 4; ++j) { w[j].x = pk2(v[j].x, v[j].y); w[j].y = pk2(v[j].z, v[j].w);
            const float a0 = __uint_as_float(w[j].x << 16), a1 = __uint_as_float(w[j].x & 0xffff0000u), a2 = __uint_as_float(w[j].y << 16), a3 = __uint_as_float(w[j].y & 0xffff0000u); s2 += (a0 * a0 + a1 * a1) + (a2 * a2 + a3 * a3); xr[64 * j] = w[j];
            am = fmaxf(am, fmaxf(fmaxf(fabsf(a0), fabsf(a1)), fmaxf(fabsf(a2), fabsf(a3)))); }
        s2 = wave_sum(s2); am = fmaxf(wave_max(am), 1e-30f); const float inv = 127.f / am;
        unsigned* q = (unsigned*)(ws + WS_XB8 + (size_t)tok * D) + lane;
#pragma unroll
        for (int j = 0; j < 4; ++j) q[64 * j] = pk4_i8(__uint_as_float(w[j].x << 16) * inv, __uint_as_float(w[j].x & 0xffff0000u) * inv, __uint_as_float(w[j].y << 16) * inv, __uint_as_float(w[j].y & 0xffff0000u) * inv);
        if (lane == 0) ((float*)(ws + WS_RS))[tok] = am * (1.f / 127.f) / sqrtf(s2 * (1.f / D) + EPS);
    }
}
__device__ __forceinline__ void combine_phase(const Params& p, int l, int gw, int ngw, int lane) {
    const unsigned char* ws = p.ws; const int* pos = (const int*)(ws + WS_POS);
    constexpr int CB = 4;
    f32x4 gfv[4];
#pragma unroll
    for (int j = 0; j < 4; ++j) gfv[j] = (l == DEPTH - 1) ? ((const f32x4*)p.in[18] + lane)[64 * j] : (f32x4){0.f, 0.f, 0.f, 0.f};
    int pp[CB][2];
#pragma unroll
    for (int k = 0; k < CB; ++k) { const int tk = gw + k * ngw; pp[k][0] = 0; pp[k][1] = 0; if (tk < NTOK) { pp[k][0] = pos[tk * 2]; pp[k][1] = pos[tk * 2 + 1]; } }
#pragma unroll 1
    for (int tb = gw; tb < NTOK; tb += CB * ngw) {
#pragma unroll
        for (int k = 0; k < CB; ++k) asm volatile("" : "+v"(pp[k][0]), "+v"(pp[k][1]));
        int pn[CB][2];
#pragma unroll
        for (int k = 0; k < CB; ++k) { const int tn = tb + (CB + k) * ngw; pn[k][0] = 0; pn[k][1] = 0; if (tn < NTOK) { pn[k][0] = pos[tn * 2]; pn[k][1] = pos[tn * 2 + 1]; } }
        CombRows R[CB];
#pragma unroll
        for (int k = 0; k < CB; ++k) { const int tk = tb + k * ngw; if (tk < NTOK) comb_load(R[k], ws, tk, pp[k][0], pp[k][1], lane); }
        __builtin_amdgcn_sched_barrier(0);
#pragma unroll
        for (int k = 0; k < CB; ++k) { const int tk = tb + k * ngw; if (tk < NTOK) comb_finish(p, R[k], gfv, l, tk, lane); }
#pragma unroll
        for (int k = 0; k < CB; ++k) { pp[k][0] = pn[k][0]; pp[k][1] = pn[k][1]; }
    }
}

#define XB_TMO      128
#define XB_XCNT(j)  (256  + 64 * (j))
#define XB_XSUB(j)  (1280 + 64 * (j))
#define XB_XGEN(j)  (2304 + 64 * (j))
#define XB_TOP      3328
#define XB_TOPGEN   3392
#define XCD_BAR_WORDS 3456
#define XB_SPIN_CAP (1u << 18)
__device__ __forceinline__ unsigned xb_ld(unsigned* p)              { return __hip_atomic_load(p, __ATOMIC_RELAXED, __HIP_MEMORY_SCOPE_AGENT); }
__device__ __forceinline__ unsigned xb_add(unsigned* p, unsigned v) { return __hip_atomic_fetch_add(p, v, __ATOMIC_RELAXED, __HIP_MEMORY_SCOPE_AGENT); }
__device__ __forceinline__ unsigned xb_xcc_id() { return (unsigned)__builtin_amdgcn_s_getreg((3 << 11) | 20) & 0xFu; }
#define XB_SPIN(cond, bar) do { unsigned _sp = 0; while (cond) { __builtin_amdgcn_s_sleep(1); \
    if ((++_sp & 255u) == 0u) { if (xb_ld(&(bar)[XB_TMO])) break; if (_sp > XB_SPIN_CAP) { atomicAdd(&(bar)[XB_TMO], 1u); break; } } } } while (0)
struct XcdBarrier { unsigned* bar; unsigned x; volatile LAS unsigned* st; };
__device__ __forceinline__ XcdBarrier xcd_barrier_post(unsigned* bar, volatile LAS unsigned* st) {
    XcdBarrier b; b.bar = bar; b.x = xb_xcc_id(); b.st = st;
    if (threadIdx.x == 0) (void)xb_add(&bar[XB_XCNT(b.x)], 1u);
    return b;
}
__device__ __forceinline__ void xcd_barrier_complete(unsigned* bar, unsigned x, unsigned& nloc, unsigned& nx) {
    const unsigned G = gridDim.x * gridDim.y * gridDim.z;
    unsigned sum, cnt, mine, sp = 0u;
    for (;;) {
        sum = 0u; cnt = 0u; mine = 0u;
#pragma unroll
        for (unsigned j = 0; j < 16; ++j) { const unsigned c = xb_ld(&bar[XB_XCNT(j)]); sum += c; cnt += (c > 0u) ? 1u : 0u; mine = (j == x) ? c : mine; }
        if (sum == G) break;
        __builtin_amdgcn_s_sleep(1);
        if ((++sp & 255u) == 0u) { if (xb_ld(&bar[XB_TMO])) break; if (sp > XB_SPIN_CAP) { atomicAdd(&bar[XB_TMO], 1u); break; } }
    }
    nloc = mine > 0u ? mine : 1u; nx = cnt > 0u ? cnt : 1u;
}
__device__ __forceinline__ void xcd_barrier(const XcdBarrier& b) {
    asm volatile("s_waitcnt vmcnt(0)" ::: "memory");
    __syncthreads();
    if (threadIdx.x == 0) {
        unsigned* bar = b.bar;
        __builtin_amdgcn_s_waitcnt(0);
        unsigned nloc = b.st[0], nx = b.st[1];
        if (nloc == 0u) { xcd_barrier_complete(bar, b.x, nloc, nx); b.st[0] = nloc; b.st[1] = nx; }
        const unsigned old = xb_add(&bar[XB_XSUB(b.x)], 1u);
        const unsigned gen = old / nloc;
        if (old + 1u == (gen + 1u) * nloc) {
            __builtin_amdgcn_fence(__ATOMIC_RELEASE, "agent");
            asm volatile("s_waitcnt vmcnt(0)" ::: "memory");
            const unsigned og = xb_add(&bar[XB_TOP], 1u);
            const unsigned tg = og / nx;
            if (og + 1u == (tg + 1u) * nx) xb_add(&bar[XB_TOPGEN], 1u);
            else XB_SPIN(xb_ld(&bar[XB_TOPGEN]) == tg, bar);
            __builtin_amdgcn_fence(__ATOMIC_ACQUIRE, "agent");
            xb_add(&bar[XB_XGEN(b.x)], 1u);
            asm volatile("s_waitcnt vmcnt(0)" ::: "memory");
        } else {
            XB_SPIN(xb_ld(&bar[XB_XGEN(b.x)]) == gen, bar);
            __builtin_amdgcn_fence(__ATOMIC_ACQUIRE, "agent");
            asm volatile("s_waitcnt vmcnt(0)" ::: "memory");
        }
    }
    __syncthreads();
}

constexpr size_t WS_BAR = 16384;
typedef const __attribute__((address_space(4))) Params* KParamsPtr;
__device__ __forceinline__ KParamsPtr kparams() { KParamsPtr kp = (KParamsPtr)__builtin_amdgcn_kernarg_segment_ptr(); asm volatile("" : "+s"(kp)); return kp; }
#define PP (*(const Params*)kparams())
__global__ void __launch_bounds__(NTHREADS, 2) k_mega(Params p_unused) {
    extern __shared__ __attribute__((aligned(16))) unsigned char lds_raw[];
    LAS unsigned char* lds = (LAS unsigned char*)lds_raw;
    volatile LAS unsigned* bst = (volatile LAS unsigned*)(lds + LDS_BYTES - 64);
    if (threadIdx.x == 0) { bst[0] = 0u; bst[1] = 0u; }
    __syncthreads();
    (void)xcd_barrier_post((unsigned*)(PP.ws + WS_BAR), bst);
#define GRID_BAR() xcd_barrier(XcdBarrier{(unsigned*)(PP.ws + WS_BAR), xb_xcc_id(), bst})
    const int b0 = blockIdx.x, nb = gridDim.x, ngw = nb * 8;
#define MK_LANE ({ int t_ = threadIdx.x; asm volatile("" : "+v"(t_)); t_ & 63; })
#define MK_GW ({ int t_ = threadIdx.x; asm volatile("" : "+v"(t_)); b0 * 8 + (t_ >> 6); })
    setup_phase(PP, b0, nb);
    wmax_phase(PP, b0, nb);
    convert_mem_phase(PP, (LAS float*)lds, b0, nb);
    prep_phase(PP, MK_GW, ngw, MK_LANE);
    GRID_BAR();
    if (b0 < 64) {
#pragma unroll 1
        for (int u = b0; u < 64; u += (nb > 64 ? 64 : nb)) phase_memkv(PP, lds, u >> 5, u & 31, 32);
    }
    { constexpr int NCV = 2 * CT_LAYER, N1 = 4032; const bool wsplit = nb > 128;
      const int ci0 = !wsplit ? b0 : (b0 < 64 ? N1 + b0 : b0 - 64), cst = !wsplit ? nb : (b0 < 64 ? 64 : nb - 64), chi = (wsplit && b0 >= 64) ? N1 : NCV;
      convert_phase(PP, (LAS float*)lds, ci0, cst, chi); }
    GRID_BAR();
#pragma unroll 1
    for (int l = 0; l < DEPTH; ++l) {
#pragma unroll 1
        for (int half = 0; half < 2; ++half) {
            phase_mix(PP, lds, l, half);
            GRID_BAR();
            phase_hgrnA(PP, lds, b0, nb);
            GRID_BAR();
            phase_diff(PP, lds, l, half);
            GRID_BAR();
            phase_gates(PP, lds, l, half);
            phase_merge(PP, lds, l, half);
            GRID_BAR();
        }
        phase_out(PP, lds, l);
        GRID_BAR();
        route_phase(PP, l, lds, b0, nb);
        GRID_BAR();
        lists_phase(PP, (LAS int*)lds, b0, nb);
        GRID_BAR();
        phase_gateup(PP, lds, l);
        GRID_BAR();
        phase_down(PP, lds, l);
        GRID_BAR();
        combine_phase(PP, l, MK_GW, ngw, MK_LANE);
        if (l + 1 < DEPTH) GRID_BAR();
    }
}

extern "C" void kernel_launch(void* const* d_in, const int* in_sizes, int n_in, void* d_out, int out_size, void* d_ws, size_t ws_size, hipStream_t stream) {
    static int grid = 0;
    if (grid == 0) {
        if (n_in != 19 || ws_size < WS_END) { fprintf(stderr, "kernel_launch: unexpected inputs (n_in %d, ws %zu)\n", n_in, ws_size); grid = -1; return; }
        int dev = 0, cus = 0, per_cu = 0;
        if (hipGetDevice(&dev) != hipSuccess || hipDeviceGetAttribute(&cus, hipDeviceAttributeMultiprocessorCount, dev) != hipSuccess) { grid = -1; return; }
        if (hipFuncSetAttribute((const void*)k_mega, hipFuncAttributeMaxDynamicSharedMemorySize, LDS_BYTES) != hipSuccess) { fprintf(stderr, "kernel_launch: hipFuncSetAttribute failed\n"); grid = -1; return; }
        if (hipOccupancyMaxActiveBlocksPerMultiprocessor(&per_cu, (const void*)k_mega, NTHREADS, LDS_BYTES) != hipSuccess || per_cu < 1) { fprintf(stderr, "kernel_launch: occupancy query reports %d\n", per_cu); }
        (void)hipGetLastError();
        grid = cus;
    }
    if (grid < 0) return;
    Params p{};
    for (int i = 0; i < 19; ++i) p.in[i] = (const float*)d_in[i];
    p.out = (float*)d_out; p.ws = (unsigned char*)d_ws; p.l = 0; p.half = 0;
    (void)hipMemsetAsync(d_ws, 0, 1 * MiB, stream);
    hipLaunchKernelGGL(k_mega, dim3(grid), dim3(NTHREADS), LDS_BYTES, stream, p);
}
```
